# Optimizing an MI355X kernel written in HIP

```python
import math
import jax, jax.numpy as jnp
from jax import lax
import numpy as np

D_MODEL = 1024
BATCH = 16
SEQ = 2048
DEPTH = 2

PLE_DIM = 256
NORM_EPS = 1e-6

SSD_HEADS = 8
SSD_HEAD_DIM = 64
SSD_WIDTH = SSD_HEADS * SSD_HEAD_DIM
SSD_GROUPS = 2
SSD_STATE = 128
SSD_CONV = 4
SSD_CHUNK = 128
SSD_CONV_CH = SSD_WIDTH + 2 * SSD_GROUPS * SSD_STATE

DIFF_HEADS = 4
DIFF_QK_DIM = 32
DIFF_V_DIM = 2 * DIFF_QK_DIM
DIFF_QK_WIDTH = DIFF_HEADS * 2 * DIFF_QK_DIM
DIFF_WIDTH = DIFF_HEADS * DIFF_V_DIM
Q_BLOCK = 128
REL_BUCKETS = 32
REL_MAX_DIST = 128

MLSTM_HEADS = 4
MLSTM_HEAD_DIM = 64
MLSTM_WIDTH = MLSTM_HEADS * MLSTM_HEAD_DIM
MLSTM_CHUNK = 128

MIX_WIDTH = SSD_WIDTH + DIFF_WIDTH + MLSTM_WIDTH
FFN_HIDDEN = 256 * (-(-(8 * D_MODEL) // (3 * 256)))

IN_SPLITS = (SSD_WIDTH, SSD_CONV_CH, SSD_HEADS,
             DIFF_QK_WIDTH, DIFF_QK_WIDTH, DIFF_WIDTH,
             MLSTM_WIDTH, MLSTM_WIDTH, MLSTM_WIDTH, MLSTM_WIDTH, MLSTM_HEADS, MLSTM_HEADS)
IN_COLS = sum(IN_SPLITS)

kernel_name = "hybrid_ssd_diffattn_mlstm_trunk"


def rmsnorm(x, w):
    xf = x.astype(jnp.float32)
    var = jnp.mean(xf * xf, axis=-1, keepdims=True)
    return (xf * lax.rsqrt(var + NORM_EPS)).astype(x.dtype) * w


def split_cols(t, sizes):
    offs = []
    acc = 0
    for s in sizes[:-1]:
        acc += s
        offs.append(acc)
    return jnp.split(t, offs, axis=-1)


def causal_depthwise_conv(x, w, b):
    k = w.shape[0]
    c = x.shape[-1]
    y = lax.conv_general_dilated(x, w[:, None, :], window_strides=(1,), padding=[(k - 1, 0)],
                                 dimension_numbers=('NWC', 'WIO', 'NWC'), feature_group_count=c)
    return y + b


def segsum_exp(a):
    n = a.shape[-1]
    cs = jnp.cumsum(a, axis=-1)
    diff = cs[..., :, None] - cs[..., None, :]
    mask = jnp.tril(jnp.ones((n, n), dtype=bool))
    return jnp.where(mask, jnp.exp(jnp.where(mask, diff, 0.0)), 0.0)


def ssd_mixer(z, xbc, dt_raw, conv_w, conv_b, dt_bias, a_log, d_skip, norm_w):
    b_, s_, _ = xbc.shape
    dtp = xbc.dtype
    G, HG, P, N, L = SSD_GROUPS, SSD_HEADS // SSD_GROUPS, SSD_HEAD_DIM, SSD_STATE, SSD_CHUNK
    nc = s_ // L
    xbc = jax.nn.silu(causal_depthwise_conv(xbc, conv_w, conv_b))
    xs, bm, cm = jnp.split(xbc, [SSD_WIDTH, SSD_WIDTH + G * N], axis=-1)
    dt = jax.nn.softplus(dt_raw.astype(jnp.float32) + dt_bias.astype(jnp.float32))
    a = -jnp.exp(a_log.astype(jnp.float32))
    a_dt = dt * a
    x = xs.reshape(b_, nc, L, G, HG, P)
    xdt = x * dt.reshape(b_, nc, L, G, HG)[..., None].astype(dtp)
    bmc = bm.reshape(b_, nc, L, G, N)
    cmc = cm.reshape(b_, nc, L, G, N)
    a_c = a_dt.reshape(b_, nc, L, G, HG).transpose(0, 3, 4, 1, 2)
    a_cs = jnp.cumsum(a_c, axis=-1)
    decay = segsum_exp(a_c)
    cb = jnp.einsum('bclgn,bcsgn->bgcls', cmc, bmc)
    y_diag = jnp.einsum('bghcls,bcsghp->bclghp', cb[:, :, None] * decay.astype(dtp), xdt)
    dstate = jnp.exp(a_cs[..., -1:] - a_cs).astype(dtp)
    states = jnp.einsum('bclgn,bghcl,bclghp->bcghpn', bmc, dstate, xdt)
    chunk_decay = jnp.exp(a_cs[..., -1]).astype(dtp)

    def step(carry, inp):
        st, dec = inp
        return carry * dec[..., None, None] + st, carry

    _, prev = lax.scan(step, jnp.zeros_like(states[:, 0]),
                       (jnp.moveaxis(states, 1, 0), jnp.moveaxis(chunk_decay, 3, 0)))
    prev = jnp.moveaxis(prev, 0, 1)
    y_off = jnp.einsum('bclgn,bcghpn,bghcl->bclghp', cmc, prev, jnp.exp(a_cs).astype(dtp))
    y = (y_diag + y_off).reshape(b_, s_, G, HG, P) + x.reshape(b_, s_, G, HG, P) * d_skip.reshape(G, HG)[:, :, None]
    y = y.reshape(b_, s_, SSD_WIDTH)
    return rmsnorm(y * jax.nn.silu(z), norm_w)


def t5_causal_bucket(dist):
    max_exact = REL_BUCKETS // 2
    is_small = dist < max_exact
    d = jnp.maximum(dist, 1).astype(jnp.float32)
    large = max_exact + (jnp.log(d / max_exact) / math.log(REL_MAX_DIST / max_exact)
                         * (REL_BUCKETS - max_exact)).astype(jnp.int32)
    large = jnp.minimum(large, REL_BUCKETS - 1)
    return jnp.where(is_small, dist, large)


def diff_attention(q, k, v, lam, lam_init, rel_bias, norm_w):
    b_, s_, h_, _, d = q.shape
    scale = d ** -0.5
    outs = []
    for j in range(s_ // Q_BLOCK):
        q0 = j * Q_BLOCK
        kl = q0 + Q_BLOCK
        qb = q[:, q0:kl]
        kb = k[:, :kl]
        vb = v[:, :kl]
        sc = jnp.einsum('bqhmd,bkhmd->bhmqk', qb, kb).astype(jnp.float32) * scale
        dist = (q0 + jnp.arange(Q_BLOCK, dtype=jnp.int32))[:, None] - jnp.arange(kl, dtype=jnp.int32)[None, :]
        bias = rel_bias[t5_causal_bucket(jnp.maximum(dist, 0))]
        sc = sc + jnp.transpose(bias, (2, 0, 1))[None, :, None].astype(jnp.float32)
        sc = jnp.where(dist >= 0, sc, -1e30)
        a = jax.nn.softmax(sc, axis=-1)
        attn = a[:, :, 0] - lam * a[:, :, 1]
        outs.append(jnp.einsum('bhqk,bkhe->bqhe', attn.astype(v.dtype), vb))
    o = jnp.concatenate(outs, axis=1)
    o = rmsnorm(o, norm_w) * (1.0 - lam_init)
    return o.reshape(b_, s_, h_ * 2 * d)


def mlstm_mixer(q, k, v, o_raw, i_raw, f_raw, i_bias, f_bias, norm_w):
    b_, s_, _ = q.shape
    dtp = q.dtype
    f32 = jnp.float32
    H, d, L = MLSTM_HEADS, MLSTM_HEAD_DIM, MLSTM_CHUNK
    nc = s_ // L
    qc = q.reshape(b_, nc, L, H, d)
    kc = k.reshape(b_, nc, L, H, d) * (d ** -0.5)
    vc = v.reshape(b_, nc, L, H, d)
    log_i = (i_raw.astype(f32) + i_bias.astype(f32)).reshape(b_, nc, L, H).transpose(0, 3, 1, 2)
    log_f = jax.nn.log_sigmoid(f_raw.astype(f32) + f_bias.astype(f32)).reshape(b_, nc, L, H).transpose(0, 3, 1, 2)
    bcum = jnp.cumsum(log_f, axis=-1)
    mask = jnp.tril(jnp.ones((L, L), dtype=bool))
    log_d = jnp.where(mask, bcum[..., :, None] - bcum[..., None, :] + log_i[..., None, :], -jnp.inf)
    m_intra = jnp.max(log_d, axis=-1)
    g = bcum[..., -1]
    w_end = g[..., None] - bcum + log_i
    m_loc = jnp.max(w_end, axis=-1)
    e_end = jnp.exp(w_end - m_loc[..., None]).astype(dtp)
    c_loc = jnp.einsum('bhcs,bcshe,bcshd->bched', e_end, vc, kc)
    n_loc = jnp.einsum('bhcs,bcshd->bchd', e_end, kc)

    def step(carry, inp):
        cm, nm, mm = carry
        cl, nl, ml, gl = inp
        m_new = jnp.maximum(gl + mm, ml)
        a_prev = jnp.exp(gl + mm - m_new).astype(cm.dtype)
        a_loc = jnp.exp(ml - m_new).astype(cm.dtype)
        c_new = cm * a_prev[..., None, None] + cl * a_loc[..., None, None]
        n_new = nm * a_prev[..., None] + nl * a_loc[..., None]
        return (c_new, n_new, m_new), (cm, nm, mm)

    init = (jnp.zeros_like(c_loc[:, 0]), jnp.zeros_like(n_loc[:, 0]), jnp.zeros((b_, H), f32))
    _, (c_prev, n_prev, m_prev) = lax.scan(
        step, init, (jnp.moveaxis(c_loc, 1, 0), jnp.moveaxis(n_loc, 1, 0),
                     jnp.moveaxis(m_loc, 2, 0), jnp.moveaxis(g, 2, 0)))
    c_prev = jnp.moveaxis(c_prev, 0, 1)
    n_prev = jnp.moveaxis(n_prev, 0, 1)
    m_prev = jnp.moveaxis(m_prev, 0, 2)
    inter_log = bcum + m_prev[..., None]
    m_t = jnp.maximum(inter_log, m_intra)
    w_inter = jnp.exp(inter_log - m_t)
    w_intra = jnp.exp(log_d - m_t[..., None])
    a_mat = jnp.einsum('bclhd,bcshd->bhcls', qc, kc) * w_intra.astype(dtp)
    wi = w_inter.transpose(0, 2, 3, 1)
    num = (jnp.einsum('bhcls,bcshe->bclhe', a_mat, vc)
           + wi[..., None].astype(dtp) * jnp.einsum('bclhd,bched->bclhe', qc, c_prev))
    den = jnp.sum(a_mat.astype(f32), axis=-1) + w_inter * jnp.einsum('bclhd,bchd->bhcl', qc, n_prev).astype(f32)
    denom = jnp.maximum(jnp.abs(den), jnp.exp(-m_t))
    h_t = (num / denom.transpose(0, 2, 3, 1)[..., None].astype(dtp)).reshape(b_, s_, H, d)
    h_t = rmsnorm(h_t, norm_w.reshape(H, d))
    out = jax.nn.sigmoid(o_raw).reshape(b_, s_, H, d) * h_t
    return out.reshape(b_, s_, MLSTM_WIDTH)


def setup_inputs(seed: int = 0) -> dict:
    key = jax.random.key(seed)
    ks = jax.random.split(key, 32)
    f32 = jnp.float32

    def nrm(k, shape, scale):
        return jax.random.normal(k, shape, f32) * scale

    x = nrm(ks[0], (BATCH, SEQ, D_MODEL), 1.0)
    p = nrm(ks[1], (DEPTH, BATCH, SEQ, PLE_DIM), 1.0)
    norm1_w = 1.0 + nrm(ks[2], (DEPTH, D_MODEL), 0.02)
    w_in = nrm(ks[3], (DEPTH, D_MODEL, IN_COLS), D_MODEL ** -0.5)
    ssd_conv_w = nrm(ks[4], (DEPTH, SSD_CONV, SSD_CONV_CH), SSD_CONV ** -0.5)
    ssd_conv_b = nrm(ks[5], (DEPTH, SSD_CONV_CH), 0.02)
    dt0 = jnp.exp(jax.random.uniform(ks[6], (DEPTH, SSD_HEADS), f32, math.log(1e-3), math.log(1e-1)))
    ssd_dt_bias = dt0 + jnp.log(-jnp.expm1(-dt0))
    ssd_a_log = jnp.log(jax.random.uniform(ks[7], (DEPTH, SSD_HEADS), f32, 1.0, 16.0))
    ssd_d = 1.0 + nrm(ks[8], (DEPTH, SSD_HEADS), 0.02)
    ssd_norm_w = 1.0 + nrm(ks[9], (DEPTH, SSD_WIDTH), 0.02)
    diff_lq1 = nrm(ks[10], (DEPTH, DIFF_QK_DIM), 0.1)
    diff_lk1 = nrm(ks[11], (DEPTH, DIFF_QK_DIM), 0.1)
    diff_lq2 = nrm(ks[12], (DEPTH, DIFF_QK_DIM), 0.1)
    diff_lk2 = nrm(ks[13], (DEPTH, DIFF_QK_DIM), 0.1)
    diff_norm_w = 1.0 + nrm(ks[14], (DEPTH, DIFF_V_DIM), 0.02)
    rel_bias = nrm(ks[15], (REL_BUCKETS, DIFF_HEADS), 0.5)
    mlstm_i_bias = nrm(ks[16], (DEPTH, MLSTM_HEADS), 0.1)
    mlstm_f_bias = jnp.linspace(3.0, 6.0, MLSTM_HEADS, dtype=f32)[None, :] + nrm(ks[17], (DEPTH, MLSTM_HEADS), 0.1)
    mlstm_norm_w = 1.0 + nrm(ks[18], (DEPTH, MLSTM_WIDTH), 0.02)
    w_out = nrm(ks[19], (DEPTH, MIX_WIDTH, D_MODEL), MIX_WIDTH ** -0.5)
    norm2_w = 1.0 + nrm(ks[20], (DEPTH, D_MODEL), 0.02)
    w_ffn_gate = nrm(ks[21], (DEPTH, D_MODEL, FFN_HIDDEN), D_MODEL ** -0.5)
    w_ffn_up = nrm(ks[22], (DEPTH, D_MODEL, FFN_HIDDEN), D_MODEL ** -0.5)
    w_ffn_down = nrm(ks[23], (DEPTH, FFN_HIDDEN, D_MODEL), FFN_HIDDEN ** -0.5)
    ple_gate_w = nrm(ks[24], (DEPTH, D_MODEL, D_MODEL), D_MODEL ** -0.5)
    ple_proj_w = nrm(ks[25], (DEPTH, PLE_DIM, D_MODEL), PLE_DIM ** -0.5)
    final_norm_w = 1.0 + nrm(ks[26], (D_MODEL,), 0.02)
    return {"x": x, "p": p, "norm1_w": norm1_w, "w_in": w_in,
            "ssd_conv_w": ssd_conv_w, "ssd_conv_b": ssd_conv_b, "ssd_dt_bias": ssd_dt_bias,
            "ssd_a_log": ssd_a_log, "ssd_d": ssd_d, "ssd_norm_w": ssd_norm_w,
            "diff_lq1": diff_lq1, "diff_lk1": diff_lk1, "diff_lq2": diff_lq2, "diff_lk2": diff_lk2,
            "diff_norm_w": diff_norm_w, "rel_bias": rel_bias,
            "mlstm_i_bias": mlstm_i_bias, "mlstm_f_bias": mlstm_f_bias, "mlstm_norm_w": mlstm_norm_w,
            "w_out": w_out, "norm2_w": norm2_w, "w_ffn_gate": w_ffn_gate, "w_ffn_up": w_ffn_up,
            "w_ffn_down": w_ffn_down, "ple_gate_w": ple_gate_w, "ple_proj_w": ple_proj_w,
            "final_norm_w": final_norm_w}


def reference(x, p, norm1_w, w_in, ssd_conv_w, ssd_conv_b, ssd_dt_bias, ssd_a_log, ssd_d, ssd_norm_w,
              diff_lq1, diff_lk1, diff_lq2, diff_lk2, diff_norm_w, rel_bias,
              mlstm_i_bias, mlstm_f_bias, mlstm_norm_w, w_out, norm2_w, w_ffn_gate, w_ffn_up,
              w_ffn_down, ple_gate_w, ple_proj_w, final_norm_w):
    b_, s_, _ = x.shape
    f32 = jnp.float32
    h = x
    for i in range(DEPTH):
        u = rmsnorm(h, norm1_w[i])
        proj = u @ w_in[i]
        z, xbc, dt_raw, dq, dk, dv, mq, mk, mv, mo, mi, mf = split_cols(proj, IN_SPLITS)
        y_ssd = ssd_mixer(z, xbc, dt_raw, ssd_conv_w[i], ssd_conv_b[i], ssd_dt_bias[i],
                          ssd_a_log[i], ssd_d[i], ssd_norm_w[i])
        lam_init = 0.8 - 0.6 * math.exp(-0.3 * i)
        lam = (jnp.exp(jnp.sum(diff_lq1[i].astype(f32) * diff_lk1[i].astype(f32)))
               - jnp.exp(jnp.sum(diff_lq2[i].astype(f32) * diff_lk2[i].astype(f32))) + lam_init)
        y_diff = diff_attention(dq.reshape(b_, s_, DIFF_HEADS, 2, DIFF_QK_DIM),
                                dk.reshape(b_, s_, DIFF_HEADS, 2, DIFF_QK_DIM),
                                dv.reshape(b_, s_, DIFF_HEADS, DIFF_V_DIM),
                                lam, lam_init, rel_bias, diff_norm_w[i])
        y_mlstm = mlstm_mixer(mq, mk, mv, mo, mi, mf, mlstm_i_bias[i], mlstm_f_bias[i], mlstm_norm_w[i])
        h = h + jnp.concatenate([y_ssd, y_diff, y_mlstm], axis=-1) @ w_out[i]
        u = rmsnorm(h, norm2_w[i])
        h = h + (jax.nn.silu(u @ w_ffn_gate[i]) * (u @ w_ffn_up[i])) @ w_ffn_down[i]
        h = h + jax.nn.sigmoid(h @ ple_gate_w[i]) * (p[i] @ ple_proj_w[i])
    return rmsnorm(h, final_norm_w)
```

```cpp
#include <hip/hip_runtime.h>
#include <cstdint>
#include <cstdio>

typedef unsigned short bf16;
constexpr int NB = 16, S = 2048, D = 1024, M = NB * S, DEPTH = 2;
constexpr int INC = 3344, FF = 2816, PLE = 256;
constexpr float EPS = 1e-6f;
constexpr int NWAVES = 8, NT = NWAVES * 64;
constexpr int PJ = 3328, NPROJ = 3584;
constexpr int O_Z = 0, O_XBC = 512, O_DQ = 1536, O_DK = 1792, O_DV = 2048, O_MQ = 2304, O_MK = 2560, O_MV = 2816, O_MO = 3072;
constexpr int SM_DT = 0, SM_MI = 8, SM_MF = 12;

constexpr size_t MiB = 1u << 20;
constexpr size_t WS_CTL = 0, CTL_ZERO_BYTES = 1 * MiB;
constexpr size_t WS_W = 1 * MiB;
constexpr size_t W_IN = 0, W_OUT = 7 * MiB, W_GU = 9 * MiB, W_DN = 20 * MiB, W_PG = 25 * MiB + 512 * 1024, W_PP = 27 * MiB + 512 * 1024, W_LAYER = 28 * MiB;
constexpr size_t WS_SSQP = 57 * MiB;
constexpr size_t WS_SMALL = 59 * MiB;
constexpr size_t WS_MISC = 61 * MiB;
constexpr size_t WS_HB = 64 * MiB;
constexpr size_t WS_PROJ = 128 * MiB;
constexpr size_t WS_HID = WS_PROJ;
constexpr size_t WS_MIX = 336 * MiB;
constexpr size_t WS_PP = WS_MIX;
constexpr size_t WS_PB = 400 * MiB;
constexpr size_t WS_HB2 = 432 * MiB;
constexpr size_t WS_XC = 432 * MiB;
constexpr size_t WS_END = 496 * MiB;

__device__ __forceinline__ float bf2f(bf16 v) { return __uint_as_float((unsigned)v << 16); }
__device__ __forceinline__ bf16 f2bf(float f) { unsigned u = __float_as_uint(f); return (bf16)((u + 0x7fffu + ((u >> 16) & 1u)) >> 16); }
__device__ __forceinline__ float sigmoidf_(float x) { return 1.f / (1.f + __expf(-x)); }
__device__ __forceinline__ float siluf_(float x) { return x * sigmoidf_(x); }
__device__ __forceinline__ float softplusf_(float x) { return x > 20.f ? x : log1pf(expf(x)); }
__device__ __forceinline__ float logsigmoidf_(float x) { return fminf(x, 0.f) - log1pf(expf(-fabsf(x))); }
__device__ __forceinline__ float log1pexp_fast(float x) { const float y = __expf(x); const float r = (y < 0.03125f) ? y * (1.f - y * (0.5f - y * 0.33333334f)) : __logf(1.f + y); return x > 15.f ? x : r; }
__device__ __forceinline__ float softplus_fast(float x) { return log1pexp_fast(x); }
__device__ __forceinline__ float logsigmoid_fast(float x) { return fminf(x, 0.f) - log1pexp_fast(-fabsf(x)); }
__device__ __forceinline__ int lane_id_asm() { int l; asm volatile("v_mbcnt_lo_u32_b32 %0, -1, 0\n\tv_mbcnt_hi_u32_b32 %0, -1, %0" : "=v"(l)); return l; }
__device__ __forceinline__ float shfl_f(float v, int src) { return __int_as_float(__builtin_amdgcn_ds_bpermute(src << 2, __float_as_int(v))); }
__device__ __forceinline__ float wave_sum(float v) {
#pragma unroll
    for (int o = 1; o < 64; o <<= 1) v += __shfl_xor(v, o);
    return v;
}
__device__ __forceinline__ float wave_sum_l(float v, int lane) {
#pragma unroll
    for (int o = 1; o < 64; o <<= 1) v += shfl_f(v, lane ^ o);
    return v;
}
__constant__ unsigned char T5_BUCKET[128] = {0,1,2,3,4,5,6,7,8,9,10,11,12,13,14,15,16,16,16,17,17,18,18,18,19,19,19,20,20,20,20,21,21,21,21,22,22,22,22,22,23,23,23,23,23,23,24,24,24,24,24,24,25,25,25,25,25,25,25,26,26,26,26,26,26,26,26,27,27,27,27,27,27,27,27,27,27,28,28,28,28,28,28,28,28,28,28,29,29,29,29,29,29,29,29,29,29,29,29,30,30,30,30,30,30,30,30,30,30,30,30,30,30,31,31,31,31,31,31,31,31,31,31,31,31,31,31,31};
enum { I_X = 0, I_P, I_N1W, I_WIN, I_CONVW, I_CONVB, I_DTB, I_ALOG, I_SSDD, I_SSDNW, I_LQ1, I_LK1, I_LQ2, I_LK2, I_DNW, I_RELB, I_MIB, I_MFB, I_MNW, I_WOUT, I_N2W, I_WG, I_WU, I_WD, I_PGW, I_PPW, I_FNW };
struct Args { const float* in[27]; float* out; unsigned char* ws; int ph_lo, ph_hi, li, pad; };
namespace pg8 {
#define PG8_LAS __attribute__((address_space(3)))
typedef unsigned short bf16_t;
typedef short bf16x8 __attribute__((ext_vector_type(8)));
typedef float f32x4 __attribute__((ext_vector_type(4)));
typedef unsigned u32x4 __attribute__((ext_vector_type(4)));
constexpr int BM = 256, BK = 64, HALF = 128, HTB = HALF * BK * 2  , STAGE_BYTES = 8 * HTB, NXCD = 8;

__host__ __device__ __forceinline__ int lds_byte(int r, int c) { const int st = (r >> 4) * 2 + (c >> 5), rr = r & 15, cc = c & 31, ob = rr * 64 + cc * 2; return st * 1024 + (ob ^ (((ob >> 9) & 1) << 5)); }
__host__ __device__ __forceinline__ void stage_rc(int b, int& R, int& C) { const int st = b / 1024, sb = b % 1024, swz = sb ^ (((sb >> 9) & 1) << 5); R = (st >> 1) * 16 + swz / 64; C = (st & 1) * 32 + (swz % 64) / 2; }
__host__ __device__ __forceinline__ int perm32(int rho) { const int n = rho >> 4, i = rho & 15; return 8 * (i >> 2) + 4 * n + (i & 3); }

struct Unit { int pm, pn, ord; };
struct Gemm { const bf16_t* A; const bf16_t* Bt; int M, N, K; };

struct StaticOrder {
    int nM, nN, nwg, G, c, WGM;
    __host__ __device__ void init(int M, int N, int G_, int c_, int wgm_ = 4) { nM = M / BM; nN = N / BM; nwg = nM * nN; G = G_; c = c_; WGM = wgm_; }
    __host__ __device__ bool next(int i, Unit& u) const {
        const long L = (long)i * G + c; if (L >= nwg) return false;
        int wgid = (int)L; { const int q = nwg / NXCD, r = nwg % NXCD, xcd = wgid % NXCD, off = wgid / NXCD; wgid = (xcd < r ? xcd * (q + 1) : r * (q + 1) + (xcd - r) * q) + off; }
        const int nig = WGM * nN, gid = wgid / nig, fm = gid * WGM, gsz = (nM - fm) < WGM ? (nM - fm) : WGM;
        u.pm = fm + ((wgid % nig) % gsz); u.pn = (wgid % nig) / gsz; return true;
    }
    __device__ __forceinline__ void a_ready(const Unit&) const {}
    __device__ __forceinline__ void done(const Unit&) const {}
};

__device__ __forceinline__ unsigned cvt_pk_bf16(float lo, float hi) { unsigned r; asm volatile("v_cvt_pk_bf16_f32 %0, %1, %2" : "=v"(r) : "v"(lo), "v"(hi)); return r; }
typedef float f32x2 __attribute__((ext_vector_type(2)));
__device__ __forceinline__ f32x2 gelu_pk(f32x2 v) {
    const f32x2 av = __builtin_elementwise_abs(v), d = av * 0.2316418882f + 1.0f;
    f32x2 t; t.x = __builtin_amdgcn_rcpf(d.x); t.y = __builtin_amdgcn_rcpf(d.y);
    f32x2 q = t * 0.5307027145f + (-0.7265760135f); q = q * t + 0.7107068705f; q = q * t + (-0.142248368f); q = q * t + 0.127414796f; q = q * t;
    const f32x2 s = (v * v) * (-0.72134752044f);
    f32x2 e; e.x = __builtin_amdgcn_exp2f(s.x); e.y = __builtin_amdgcn_exp2f(s.y);
    const f32x2 m = v * (q * e), r = v - m;
    f32x2 o; o.x = v.x < 0.f ? m.x : r.x; o.y = v.y < 0.f ? m.y : r.y; return o;
}

template <int ACT  > struct EpiBf16 {
    static constexpr bool PERM = true, AFTER_DRAIN = false; static_assert(ACT == 0 || ACT == 1, "EpiBf16: ACT is 0 (none) or 1 (gelu_pk)");
    bf16_t* O; int ldc; const float* bias; int split_cols; size_t split_stride; float scale0;
    __device__ __forceinline__ void operator()(const f32x4 (&acc)[2][2][4][2], const Unit& u, int wr, int wc, int fr, int fq) const {
        const int row0 = u.pm * BM + wr * 64 + fr; int colt = u.pn * BM; bf16_t* base = O;
        float sc = 1.f; if (split_cols) { const int t = colt / split_cols; base += (size_t)t * split_stride; colt -= t * split_cols; if (t == 0) sc = scale0; }
        const int col0 = colt + wc * 32 + 8 * fq, bcol0 = u.pn * BM + wc * 32 + 8 * fq;
        f32x4 bv[2][2];
#pragma unroll
        for (int bj = 0; bj < 2; ++bj)
#pragma unroll
            for (int n = 0; n < 2; ++n) bv[bj][n] = bias ? *(const f32x4*)(bias + bcol0 + bj * HALF + 4 * n) : (f32x4){0.f, 0.f, 0.f, 0.f};
#pragma unroll
        for (int ai = 0; ai < 2; ++ai)
#pragma unroll
            for (int m = 0; m < 4; ++m) { bf16_t* rowp = base + (size_t)(row0 + ai * HALF + m * 16) * ldc + col0;
#pragma unroll
                for (int bj = 0; bj < 2; ++bj) { f32x4 v0 = acc[ai][bj][m][0] + bv[bj][0], v1 = acc[ai][bj][m][1] + bv[bj][1];
                    if (ACT == 1) { f32x2 a = gelu_pk((f32x2){v0[0], v0[1]}), b = gelu_pk((f32x2){v0[2], v0[3]}), c = gelu_pk((f32x2){v1[0], v1[1]}), d = gelu_pk((f32x2){v1[2], v1[3]});
                        v0 = (f32x4){a.x, a.y, b.x, b.y}; v1 = (f32x4){c.x, c.y, d.x, d.y}; }
                    v0 = v0 * sc; v1 = v1 * sc; u32x4 w; w.x = cvt_pk_bf16(v0[0], v0[1]); w.y = cvt_pk_bf16(v0[2], v0[3]); w.z = cvt_pk_bf16(v1[0], v1[1]); w.w = cvt_pk_bf16(v1[2], v1[3]);
                    *(u32x4*)(rowp + bj * HALF) = w; } }
    }
};
typedef unsigned u32x2 __attribute__((ext_vector_type(2)));
constexpr float RMS_EPS = 1e-6f;
__device__ __forceinline__ float row_rstd(const float* ssqp, int row, int fr_, int fq) {
    const f32x4 p = *(const f32x4*)(ssqp + (size_t)row * 16 + 4 * fq);
    float s = (p[0] + p[1]) + (p[2] + p[3]);
    const int ln_ = fr_ | (fq << 4); s += shfl_f(s, ln_ ^ 16); s += shfl_f(s, ln_ ^ 32);
    return rsqrtf(s * (1.0f / 1024.0f) + RMS_EPS);
}
__device__ __forceinline__ float fast_sigmoid(float x) { return __builtin_amdgcn_rcpf(1.0f + __expf(-x)); }
struct EpiProj {
    static constexpr bool PERM = true, AFTER_DRAIN = false;
    bf16_t* proj; float* small_; const PG8_LAS float* rtab;
    __device__ __forceinline__ void operator()(const f32x4 (&acc)[2][2][4][2], const Unit& u, int wr, int wc, int fr, int fq) const {
        const int row0 = u.pm * BM + wr * 64 + fr;
#pragma unroll
        for (int ai = 0; ai < 2; ++ai)
#pragma unroll
            for (int m = 0; m < 4; ++m) {
                const int row = row0 + ai * HALF + m * 16; const float rs = rtab[u.ord * BM + ai * HALF + wr * 64 + m * 16 + fr] * ((u.pn == 6) ? 0.25503486f : 1.0f);
                if (u.pn < 13) {
                    bf16_t* rowp = proj + (size_t)row * 3328 + u.pn * BM + wc * 32 + 8 * fq;
#pragma unroll
                    for (int bj = 0; bj < 2; ++bj) { const f32x4 v0 = acc[ai][bj][m][0] * rs, v1 = acc[ai][bj][m][1] * rs;
                        u32x4 w; w.x = cvt_pk_bf16(v0[0], v0[1]); w.y = cvt_pk_bf16(v0[2], v0[3]); w.z = cvt_pk_bf16(v1[0], v1[1]); w.w = cvt_pk_bf16(v1[2], v1[3]);
                        *(u32x4*)(rowp + bj * HALF) = w; }
                } else if (wc == 0 && fq < 2) {
                    float* sp = small_ + (size_t)row * 16 + 8 * fq;
                    *(f32x4*)sp = acc[ai][0][m][0] * rs; *(f32x4*)(sp + 4) = acc[ai][0][m][1] * rs;
                }
            }
    }
};
struct EpiGateUp {
    static constexpr bool PERM = true, AFTER_DRAIN = false;
    bf16_t* hid; const PG8_LAS float* rtab;
    __device__ __forceinline__ void operator()(const f32x4 (&acc)[2][2][4][2], const Unit& u, int wr, int wc, int fr, int fq) const {
        const int row0 = u.pm * BM + wr * 64 + fr;
#pragma unroll
        for (int ai = 0; ai < 2; ++ai)
#pragma unroll
            for (int m = 0; m < 4; ++m) {
                const int row = row0 + ai * HALF + m * 16; const float rs = rtab[u.ord * BM + ai * HALF + wr * 64 + m * 16 + fr];
                float h[8];
#pragma unroll
                for (int n = 0; n < 2; ++n)
#pragma unroll
                    for (int j = 0; j < 4; ++j) { const float g = acc[ai][0][m][n][j] * rs, up = acc[ai][1][m][n][j] * rs; h[4 * n + j] = g * fast_sigmoid(g) * up; }
                u32x4 w; w.x = cvt_pk_bf16(h[0], h[1]); w.y = cvt_pk_bf16(h[2], h[3]); w.z = cvt_pk_bf16(h[4], h[5]); w.w = cvt_pk_bf16(h[6], h[7]);
                *(u32x4*)(hid + (size_t)row * 2816 + u.pn * HALF + wc * 32 + 8 * fq) = w;
            }
    }
};
template <int MODE, bool BASEF32> struct EpiRes {
    static constexpr bool PERM = true, AFTER_DRAIN = false;
    const void* base; bf16_t* out; float* ssqp; const bf16_t* pp;
    __device__ __forceinline__ void operator()(const f32x4 (&acc)[2][2][4][2], const Unit& u, int wr, int wc, int fr, int fq) const {
        const int row0 = u.pm * BM + wr * 64 + fr, col0 = u.pn * BM + wc * 32 + 8 * fq;
#pragma unroll
        for (int ai = 0; ai < 2; ++ai)
#pragma unroll
            for (int m = 0; m < 4; ++m) {
                const int row = row0 + ai * HALF + m * 16; const size_t off = (size_t)row * 1024 + col0; float ss = 0.f;
                float b[2][8]; u32x4 pw[2];
#pragma unroll
                for (int bj = 0; bj < 2; ++bj) { const size_t o = off + bj * HALF;
                    if (BASEF32) { const f32x4 b0 = *(const f32x4*)((const float*)base + o), b1 = *(const f32x4*)((const float*)base + o + 4);
                        b[bj][0] = b0[0]; b[bj][1] = b0[1]; b[bj][2] = b0[2]; b[bj][3] = b0[3]; b[bj][4] = b1[0]; b[bj][5] = b1[1]; b[bj][6] = b1[2]; b[bj][7] = b1[3]; }
                    else { const u32x4 w = *(const u32x4*)((const bf16_t*)base + o);
#pragma unroll
                        for (int j = 0; j < 4; ++j) { b[bj][2 * j] = __uint_as_float(w[j] << 16); b[bj][2 * j + 1] = __uint_as_float(w[j] & 0xffff0000u); } }
                    if (MODE == 2) pw[bj] = *(const u32x4*)(pp + o); }
#pragma unroll
                for (int bj = 0; bj < 2; ++bj) { const size_t o = off + bj * HALF; float v[8];
#pragma unroll
                    for (int j = 0; j < 8; ++j) { float a = acc[ai][bj][m][j >> 2][j & 3];
                        if (MODE == 2) { const unsigned w = pw[bj][j >> 1]; a = fast_sigmoid(a) * __uint_as_float((j & 1) ? (w & 0xffff0000u) : (w << 16)); }
                        v[j] = b[bj][j] + a; ss += v[j] * v[j]; }
                    u32x4 hw; hw.x = cvt_pk_bf16(v[0], v[1]); hw.y = cvt_pk_bf16(v[2], v[3]); hw.z = cvt_pk_bf16(v[4], v[5]); hw.w = cvt_pk_bf16(v[6], v[7]);
                    *(u32x4*)(out + o) = hw; }
                if (MODE != 1) { const int ln_ = fr | (fq << 4); ss += shfl_f(ss, ln_ ^ 16); ss += shfl_f(ss, ln_ ^ 32); if (fq == 0) ssqp[(size_t)row * 16 + u.pn * 4 + wc] = ss; }
            }
    }
};
template <class Epi, class Sched, bool ALIGN_EPI = false, bool SP2 = false>
__device__ __forceinline__ void gemm_phase(const int wave_s, PG8_LAS unsigned char* lds, const Gemm g, const Sched& S, const Epi& E) {
    const int tid_ = wave_s * 64 + lane_id_asm();
    const int tid = tid_, wid = __builtin_amdgcn_readfirstlane(tid >> 6), lane = tid & 63, wr = wid >> 2, wc = wid & 3, fr = lane & 15, fq = lane >> 4;
    const int K = g.K, nt = K / BK;
    unsigned voffA[2], voffB[2];
#pragma unroll
    for (int i = 0; i < 2; ++i) { int R, C; stage_rc(tid * 16 + i * 8192, R, C); const int Rb = Epi::PERM ? ((R & ~31) + perm32(R & 31)) : R;
        voffA[i] = (unsigned)(R * K + C) * 2u; voffB[i] = (unsigned)(Rb * K + C) * 2u; }
    const size_t kstep = (size_t)(BK * 2);
    const size_t hstep = (size_t)HALF * K * 2;
    const size_t tstep = 2 * hstep;
    const unsigned ldsw = (unsigned)wid * 1024u;
    const int aoff = lds_byte(wr * 64 + fr, fq * 8), boff = lds_byte(wc * 32 + fr, fq * 8);
#define PG8_SA(b, h) (((b) * 2 + (h)) * HTB)
#define PG8_SB(b, h) ((4 + (b) * 2 + (h)) * HTB)
#define PG8_STAGE(bufoff, gbase, voff) do { _Pragma("unroll") for (int _i = 0; _i < 2; ++_i) \
        __builtin_amdgcn_global_load_lds((const unsigned*)((const char*)(gbase) + (voff)[_i]), (PG8_LAS unsigned*)(lds + (bufoff) + ldsw + _i * 8192), 16, 0, 0); } while (0)
#define PG8_LDA(dst, b, h) do { _Pragma("unroll") for (int m = 0; m < 4; ++m) _Pragma("unroll") for (int k = 0; k < 2; ++k) dst[m][k] = *(const PG8_LAS bf16x8*)(lds + PG8_SA(b, h) + aoff + m * 2048 + k * 1024); } while (0)
#define PG8_LDB(dst, b, h) do { _Pragma("unroll") for (int n = 0; n < 2; ++n) _Pragma("unroll") for (int k = 0; k < 2; ++k) dst[n][k] = *(const PG8_LAS bf16x8*)(lds + PG8_SB(b, h) + boff + n * 2048 + k * 1024); } while (0)
#define PG8_MMA(ai, bj, At, Bt) do { __builtin_amdgcn_s_setprio(1); _Pragma("unroll") for (int m = 0; m < 4; ++m) _Pragma("unroll") for (int n = 0; n < 2; ++n) _Pragma("unroll") for (int k = 0; k < 2; ++k) \
        acc[ai][bj][m][n] = __builtin_amdgcn_mfma_f32_16x16x32_bf16(Bt[n][k], At[m][k], acc[ai][bj][m][n], 0, 0, 0); __builtin_amdgcn_s_setprio(0); } while (0)
#define PG8_WAIT_V(n) asm volatile("s_waitcnt vmcnt(" #n ")" ::: "memory")
#define PG8_WAIT_L(n) asm volatile("s_waitcnt lgkmcnt(" #n ")" ::: "memory")
#define PG8_BAR __builtin_amdgcn_s_barrier()
#define PG8_SCHED __builtin_amdgcn_sched_barrier(0)
    Unit cur, nxt; int ui = 0;
    if (!S.next(0, cur)) return;
    cur.ord = 0;
    f32x4 acc[2][2][4][2];
#pragma unroll
    for (int a = 0; a < 2; ++a)
#pragma unroll
        for (int b = 0; b < 2; ++b)
#pragma unroll
            for (int m = 0; m < 4; ++m)
#pragma unroll
                for (int n = 0; n < 2; ++n) acc[a][b][m][n] = (f32x4){0.f, 0.f, 0.f, 0.f};
    bf16x8 At[4][2], B0[2][2], B1[2][2];
    const char* cA = (const char*)g.A + (size_t)cur.pm * tstep; const char* cB = (const char*)g.Bt + (size_t)cur.pn * tstep;
    S.a_ready(cur);
    if constexpr (SP2) {
        PG8_STAGE(PG8_SB(0, 0), cB, voffB); PG8_STAGE(PG8_SB(0, 1), cB + hstep, voffB); PG8_STAGE(PG8_SA(0, 0), cA, voffA); PG8_STAGE(PG8_SA(0, 1), cA + hstep, voffA);
        if (wr == 1) PG8_BAR;
        PG8_WAIT_V(2); PG8_BAR;
        PG8_STAGE(PG8_SB(1, 0), cB + kstep, voffB); PG8_STAGE(PG8_SA(1, 0), cA + kstep, voffA); PG8_STAGE(PG8_SB(1, 1), cB + hstep + kstep, voffB);
        PG8_WAIT_V(6); PG8_BAR;
    } else {
        PG8_STAGE(PG8_SB(0, 0), cB, voffB); PG8_STAGE(PG8_SA(0, 0), cA, voffA); PG8_STAGE(PG8_SB(0, 1), cB + hstep, voffB); PG8_STAGE(PG8_SA(0, 1), cA + hstep, voffA);
        if (wr == 1) PG8_BAR;
        PG8_WAIT_V(4); PG8_BAR;
        PG8_STAGE(PG8_SB(1, 0), cB + kstep, voffB); PG8_STAGE(PG8_SA(1, 0), cA + kstep, voffA); PG8_STAGE(PG8_SB(1, 1), cB + hstep + kstep, voffB);
        PG8_WAIT_V(6); PG8_BAR;
    }
    for (;;) {
        const bool has_next = S.next(ui + 1, nxt); nxt.ord = ui + 1;
        const char* nA = has_next ? (const char*)g.A + (size_t)nxt.pm * tstep : cA; const char* nB = has_next ? (const char*)g.Bt + (size_t)nxt.pn * tstep : cB;
        for (int t = 0; t < nt; t += 2) {
            const bool last = (t == nt - 2);
            const char* a1 = cA + (size_t)(t + 1) * kstep;
            const char* a2 = last ? nA : cA + (size_t)(t + 2) * kstep; const char* b2 = last ? nB : cB + (size_t)(t + 2) * kstep;
            const char* a3 = a2 + kstep; const char* b3 = b2 + kstep;
            if (last && has_next) S.a_ready(nxt);
            if constexpr (SP2) {
            PG8_LDB(B0, 0, 0); PG8_LDB(B1, 0, 1); PG8_SCHED; PG8_LDA(At, 0, 0); PG8_STAGE(PG8_SA(1, 1), a1 + hstep, voffA);
            PG8_WAIT_V(8); PG8_WAIT_L(0); PG8_BAR; PG8_MMA(0, 0, At, B0); PG8_MMA(0, 1, At, B1); PG8_BAR; PG8_SCHED;
            PG8_LDA(At, 0, 1); PG8_STAGE(PG8_SB(0, 0), b2, voffB); PG8_STAGE(PG8_SB(0, 1), b2 + hstep, voffB); PG8_STAGE(PG8_SA(0, 0), a2, voffA);
            PG8_WAIT_V(8); PG8_WAIT_L(0); PG8_BAR; PG8_MMA(1, 0, At, B0); PG8_MMA(1, 1, At, B1); PG8_BAR; PG8_SCHED;
            PG8_LDB(B0, 1, 0); PG8_LDB(B1, 1, 1); PG8_SCHED; PG8_LDA(At, 1, 0); PG8_STAGE(PG8_SA(0, 1), a2 + hstep, voffA);
            PG8_WAIT_V(8); PG8_WAIT_L(0); PG8_BAR; PG8_MMA(0, 0, At, B0); PG8_MMA(0, 1, At, B1); PG8_BAR; PG8_SCHED;
            PG8_LDA(At, 1, 1); PG8_STAGE(PG8_SB(1, 0), b3, voffB); PG8_STAGE(PG8_SB(1, 1), b3 + hstep, voffB); PG8_STAGE(PG8_SA(1, 0), a3, voffA);
            PG8_WAIT_V(8); PG8_WAIT_L(0); PG8_BAR; PG8_MMA(1, 0, At, B0); PG8_MMA(1, 1, At, B1); PG8_BAR; PG8_SCHED;
            } else {
            PG8_LDB(B0, 0, 0); PG8_SCHED; PG8_LDA(At, 0, 0); PG8_STAGE(PG8_SA(1, 1), a1 + hstep, voffA);
            PG8_WAIT_L(8); PG8_BAR; PG8_WAIT_L(0); PG8_MMA(0, 0, At, B0); PG8_BAR; PG8_SCHED;
            PG8_LDB(B1, 0, 1); PG8_STAGE(PG8_SB(0, 0), b2, voffB);
            PG8_BAR; PG8_WAIT_L(0); PG8_MMA(0, 1, At, B1); PG8_BAR;
            PG8_LDA(At, 0, 1); PG8_STAGE(PG8_SA(0, 0), a2, voffA);
            PG8_BAR; PG8_WAIT_L(0); PG8_MMA(1, 0, At, B0); PG8_BAR; PG8_SCHED;
            PG8_STAGE(PG8_SB(0, 1), b2 + hstep, voffB);
            PG8_WAIT_V(6); PG8_BAR; PG8_MMA(1, 1, At, B1); PG8_BAR;
            PG8_LDB(B0, 1, 0); PG8_SCHED; PG8_LDA(At, 1, 0); PG8_STAGE(PG8_SA(0, 1), a2 + hstep, voffA);
            PG8_WAIT_L(8); PG8_BAR; PG8_WAIT_L(0); PG8_MMA(0, 0, At, B0); PG8_BAR; PG8_SCHED;
            PG8_LDB(B1, 1, 1); PG8_STAGE(PG8_SB(1, 0), b3, voffB);
            PG8_BAR; PG8_WAIT_L(0); PG8_MMA(0, 1, At, B1); PG8_BAR;
            PG8_LDA(At, 1, 1); PG8_STAGE(PG8_SA(1, 0), a3, voffA);
            PG8_BAR; PG8_WAIT_L(0); PG8_MMA(1, 0, At, B0); PG8_BAR; PG8_SCHED;
            PG8_STAGE(PG8_SB(1, 1), b3 + hstep, voffB);
            PG8_WAIT_V(6); PG8_BAR; PG8_MMA(1, 1, At, B1); PG8_BAR;
            }
        }
        if constexpr (ALIGN_EPI) { if (wr == 0) PG8_BAR; }
        if constexpr (!Epi::AFTER_DRAIN) { const int l2_ = lane_id_asm(); E(acc, cur, wr, wc, l2_ & 15, l2_ >> 4); S.done(cur); }
        if (!has_next) break;
#pragma unroll
        for (int a = 0; a < 2; ++a)
#pragma unroll
            for (int b = 0; b < 2; ++b)
#pragma unroll
                for (int m = 0; m < 4; ++m)
#pragma unroll
                    for (int n = 0; n < 2; ++n) acc[a][b][m][n] = (f32x4){0.f, 0.f, 0.f, 0.f};
        cur = nxt; cA = nA; cB = nB; ++ui;
        if constexpr (ALIGN_EPI) { if (wr == 1) PG8_BAR; }
    }
    PG8_WAIT_V(0);
    if constexpr (!ALIGN_EPI) { if (wr == 0) PG8_BAR; }
    PG8_BAR;
    if constexpr (Epi::AFTER_DRAIN) { E.fused(acc, cur, wr, wc, fr, fq, lds, wid, lane); S.done(cur); }
#undef PG8_SA
#undef PG8_SB
#undef PG8_STAGE
#undef PG8_LDA
#undef PG8_LDB
#undef PG8_MMA
#undef PG8_WAIT_V
#undef PG8_WAIT_L
#undef PG8_BAR
#undef PG8_SCHED
}
}
#define GAS __attribute__((address_space(1)))
#define LAS __attribute__((address_space(3)))
typedef unsigned v4u __attribute__((ext_vector_type(4)));
typedef float f32x4 __attribute__((ext_vector_type(4)));
#define XB_TMO      128
#define XB_XCNT(j)  (256  + 64 * (j))
#define XB_XSUB(j)  (1280 + 64 * (j))
#define XB_XGEN(j)  (2304 + 64 * (j))
#define XB_TOP      3328
#define XB_TOPGEN   3392
#define XCD_BAR_WORDS 3456
#define XB_SPIN_CAP (1u << 18)

__device__ __forceinline__ unsigned xb_ld(unsigned* p)              { return __hip_atomic_load(p, __ATOMIC_RELAXED, __HIP_MEMORY_SCOPE_AGENT); }
__device__ __forceinline__ unsigned xb_add(unsigned* p, unsigned v) { return __hip_atomic_fetch_add(p, v, __ATOMIC_RELAXED, __HIP_MEMORY_SCOPE_AGENT); }
__device__ __forceinline__ unsigned xb_xcc_id() { return (unsigned)__builtin_amdgcn_s_getreg((3 << 11) | 20) & 0xFu; }
#define XB_SPIN(cond, bar) do { unsigned _sp = 0; while (cond) { __builtin_amdgcn_s_sleep(1); \
    if ((++_sp & 255u) == 0u) { if (xb_ld(&(bar)[XB_TMO])) break; if (_sp > XB_SPIN_CAP) { atomicAdd(&(bar)[XB_TMO], 1u); break; } } } } while (0)

struct XcdBarrier {
    unsigned* bar; unsigned x;
    volatile LAS unsigned* st;
    int w;
};

__device__ __forceinline__ XcdBarrier xcd_barrier_post(unsigned* bar, volatile LAS unsigned* st, int w) {
    XcdBarrier b; b.bar = bar; b.x = xb_xcc_id(); b.st = st; b.w = w;
    if (w == 0 && lane_id_asm() == 0) (void)xb_add(&bar[XB_XCNT(b.x)], 1u);
    return b;
}
__device__ __forceinline__ void xcd_barrier_complete(unsigned* bar, unsigned x, unsigned& nloc, unsigned& nx) {
    const unsigned G = gridDim.x * gridDim.y * gridDim.z;
    unsigned sum, cnt, mine, sp = 0u;
    for (;;) {
        sum = 0u; cnt = 0u; mine = 0u;
#pragma unroll
        for (unsigned j = 0; j < 16; ++j) { const unsigned c = xb_ld(&bar[XB_XCNT(j)]); sum += c; cnt += (c > 0u) ? 1u : 0u; mine = (j == x) ? c : mine; }
        if (sum == G) break;
        __builtin_amdgcn_s_sleep(1);
        if ((++sp & 255u) == 0u) { if (xb_ld(&bar[XB_TMO])) break; if (sp > XB_SPIN_CAP) { atomicAdd(&bar[XB_TMO], 1u); break; } }
    }
    nloc = mine > 0u ? mine : 1u; nx = cnt > 0u ? cnt : 1u;
}

__device__ __forceinline__ void xcd_barrier(const XcdBarrier& b) {
    asm volatile("s_waitcnt vmcnt(0)" ::: "memory");
    __syncthreads();
    if (b.w == 0 && lane_id_asm() == 0) {
        unsigned* bar = b.bar;
        __builtin_amdgcn_s_waitcnt(0);
        unsigned nloc = b.st[0], nx = b.st[1];
        if (nloc == 0u) { xcd_barrier_complete(bar, b.x, nloc, nx); b.st[0] = nloc; b.st[1] = nx; }
        const unsigned old = xb_add(&bar[XB_XSUB(b.x)], 1u);
        const unsigned gen = old / nloc;
        if (old + 1u == (gen + 1u) * nloc) {
            __builtin_amdgcn_fence(__ATOMIC_RELEASE, "agent");
            asm volatile("s_waitcnt vmcnt(0)" ::: "memory");
            const unsigned og = xb_add(&bar[XB_TOP], 1u);
            const unsigned tg = og / nx;
            if (og + 1u == (tg + 1u) * nx) xb_add(&bar[XB_TOPGEN], 1u);
            else XB_SPIN(xb_ld(&bar[XB_TOPGEN]) == tg, bar);
            __builtin_amdgcn_fence(__ATOMIC_ACQUIRE, "agent");
            xb_add(&bar[XB_XGEN(b.x)], 1u);
            asm volatile("s_waitcnt vmcnt(0)" ::: "memory");
        } else {
            XB_SPIN(xb_ld(&bar[XB_XGEN(b.x)]) == gen, bar);
            __builtin_amdgcn_fence(__ATOMIC_ACQUIRE, "agent");
            asm volatile("s_waitcnt vmcnt(0)" ::: "memory");
        }
    }
    __syncthreads();
}
namespace mx {
typedef short bf16x8 __attribute__((ext_vector_type(8)));
typedef short s16x4 __attribute__((ext_vector_type(4)));
typedef float f32x16 __attribute__((ext_vector_type(16)));
typedef __bf16 bf16x2_t __attribute__((ext_vector_type(2)));
typedef float f32x2_t __attribute__((ext_vector_type(2)));
typedef unsigned u32x2m __attribute__((ext_vector_type(2)));
typedef LAS bf16* lbf;
typedef LAS float* lf32;
#define WG_BAR() __syncthreads()
#define LAUNDER(x) asm volatile("" : "+v"(x))
__device__ __forceinline__ int crow(int i, int h) { return (i & 3) + 8 * (i >> 2) + 4 * h; }
__device__ __forceinline__ unsigned cvt2(float lo, float hi) { f32x2_t v = {lo, hi}; bf16x2_t b = __builtin_convertvector(v, bf16x2_t); return __builtin_bit_cast(unsigned, b); }
__device__ __forceinline__ f32x16 zero16() { f32x16 z; for (int i = 0; i < 16; ++i) z[i] = 0.f; return z; }
typedef short v4i16_t __attribute__((ext_vector_type(4)));
__device__ __forceinline__ s16x4 tr4(lbf p) { return __builtin_bit_cast(s16x4, __builtin_amdgcn_ds_read_tr16_b64_v4i16((LAS v4i16_t*)p)); }
__device__ __forceinline__ bf16x8 frag_n(lbf img, int P, int row0, int k0, int lane) { return *(const LAS bf16x8*)(img + (row0 + (lane & 31)) * P + k0 + 8 * (lane >> 5)); }
__device__ __forceinline__ bf16x8 frag_tr(lbf img, int P, int k0, int col0, int lane) {
    const int l16 = lane & 15; lbf a = img + (k0 + 8 * (lane >> 5) + (l16 >> 2)) * P + col0 + 16 * ((lane >> 4) & 1) + 4 * (l16 & 3);
    const s16x4 lo = tr4(a), hi = tr4(a + 4 * P); return __builtin_shufflevector(lo, hi, 0, 1, 2, 3, 4, 5, 6, 7);
}
__device__ __forceinline__ bf16x8 frag_tp(lbf img, int P, int k0, int col0, int lane) {
    const int l16 = lane & 15; lbf a = img + (k0 + 4 * (lane >> 5) + (l16 >> 2)) * P + col0 + 16 * ((lane >> 4) & 1) + 4 * (l16 & 3);
    const s16x4 lo = tr4(a), hi = tr4(a + 8 * P); return __builtin_shufflevector(lo, hi, 0, 1, 2, 3, 4, 5, 6, 7);
}
template <bool ATR, bool BTR>
__device__ __forceinline__ void mma(f32x16& acc, lbf A, int PA, int a0, lbf B, int PB, int b0, int K, int lane) {
    for (int k0 = 0; k0 < K; k0 += 16) {
        const bf16x8 a = ATR ? frag_tr(A, PA, k0, a0, lane) : frag_n(A, PA, a0, k0, lane);
        const bf16x8 b = BTR ? frag_tr(B, PB, k0, b0, lane) : frag_n(B, PB, b0, k0, lane);
        acc = __builtin_amdgcn_mfma_f32_32x32x16_bf16(a, b, acc, 0, 0, 0);
    }
}
__device__ __forceinline__ v4u pack8(const float (&v)[8]) { return (v4u){cvt2(v[0], v[1]), cvt2(v[2], v[3]), cvt2(v[4], v[5]), cvt2(v[6], v[7])}; }
__device__ __forceinline__ void scan_add128(float& a, float& b, int lane) {
    const float pair = a + b; float x = pair;
#pragma unroll
    for (int o = 1; o < 64; o <<= 1) { const float y = shfl_f(x, lane - o); if (lane >= o) x += y; }
    const float excl = x - pair; a = excl + a; b = excl + pair;
}
__device__ __forceinline__ void scan_max128(float& a, float& b, int lane) {
    const float pair = fmaxf(a, b); float x = pair;
#pragma unroll
    for (int o = 1; o < 64; o <<= 1) { const float y = shfl_f(x, lane - o); if (lane >= o) x = fmaxf(x, y); }
    float excl = shfl_f(x, lane - 1); if (lane == 0) excl = -3.0e38f;
    a = fmaxf(excl, a); b = fmaxf(excl, pair);
}
__device__ __forceinline__ float wave_max(float v, int lane) {
#pragma unroll
    for (int o = 1; o < 64; o <<= 1) v = fmaxf(v, shfl_f(v, lane ^ o));
    return v;
}
__device__ __forceinline__ void unpack8(const v4u w, float (&f)[8]) {
#pragma unroll
    for (int j = 0; j < 4; ++j) { f[2 * j] = __uint_as_float(w[j] << 16); f[2 * j + 1] = __uint_as_float(w[j] & 0xffff0000u); }
}

struct MixCtx {
    const bf16* PROJ; const float* SMALL; bf16* MIX; unsigned char* ws; const float* const* in; int L; float* states; float* cloc; bf16* prev; bf16* cprev;
};
constexpr size_t MS_CD = 0;
constexpr size_t MS_G = 16384;
constexpr size_t MS_ML = 32768;
constexpr size_t MS_MP = 49152;
constexpr size_t MS_NL = 65536;

template <int NR, class F>
__device__ __forceinline__ void conv8(const bf16* raw, int s0  , int r0, const float* cw, const float* cb, int cc, F f) {
    float w[4][8], bias[8];
#pragma unroll
    for (int k = 0; k < 4; ++k) { const f32x4 a = *(const f32x4*)(cw + k * 1024 + cc), b = *(const f32x4*)(cw + k * 1024 + cc + 4);
        w[k][0] = a.x; w[k][1] = a.y; w[k][2] = a.z; w[k][3] = a.w; w[k][4] = b.x; w[k][5] = b.y; w[k][6] = b.z; w[k][7] = b.w; }
    { const f32x4 a = *(const f32x4*)(cb + cc), b = *(const f32x4*)(cb + cc + 4); bias[0] = a.x; bias[1] = a.y; bias[2] = a.z; bias[3] = a.w; bias[4] = b.x; bias[5] = b.y; bias[6] = b.z; bias[7] = b.w; }
    float win[3][8];
#pragma unroll
    for (int k = 0; k < 3; ++k) { const int rr = r0 - 3 + k;
        if (s0 + rr >= 0) { const v4u u = *(const v4u*)(raw + (ptrdiff_t)rr * PJ); unpack8(u, win[k]); }
        else {
#pragma unroll
            for (int j = 0; j < 8; ++j) win[k][j] = 0.f; } }
#pragma unroll
    for (int i = 0; i < NR; ++i) {
        float cur[8]; { const v4u u = *(const v4u*)(raw + (ptrdiff_t)(r0 + i) * PJ); unpack8(u, cur); }
        float v[8];
#pragma unroll
        for (int j = 0; j < 8; ++j) { const float a = bias[j] + w[0][j] * win[0][j] + w[1][j] * win[1][j] + w[2][j] * win[2][j] + w[3][j] * cur[j]; v[j] = a * __builtin_amdgcn_rcpf(1.0f + __expf(-a)); }
        f(r0 + i, v);
#pragma unroll
        for (int j = 0; j < 8; ++j) { win[0][j] = win[1][j]; win[1][j] = win[2][j]; win[2][j] = cur[j]; }
    }
}

__device__ __forceinline__ void ssd_scalars(const MixCtx& c, int t0, int hd, lf32 DT, lf32 ACS, int lane) {
    const float dtb = c.in[I_DTB][c.L * 8 + hd], A = -__expf(c.in[I_ALOG][c.L * 8 + hd]);
    const float d0 = softplus_fast(c.SMALL[(size_t)(t0 + 2 * lane) * 16 + SM_DT + hd] + dtb), d1 = softplus_fast(c.SMALL[(size_t)(t0 + 2 * lane + 1) * 16 + SM_DT + hd] + dtb);
    float a0 = d0 * A, a1 = d1 * A; scan_add128(a0, a1, lane);
    DT[2 * lane] = d0; DT[2 * lane + 1] = d1; ACS[2 * lane] = a0; ACS[2 * lane + 1] = a1;
}

__device__ __forceinline__ void ssd_states_unit(const MixCtx& c, int u, LAS unsigned char* lds, int wave, int lane) {
    const int g = u & 1, bc = u >> 1, t0 = bc * 128, s0 = (bc & 15) * 128, tid = wave * 64 + lane;
    lf32 DT = (lf32)lds, ACS = (lf32)(lds + 2048);
    lbf BL = (lbf)(lds + 4096), XS = (lbf)(lds + 4096 + 40960);
    float* STATES = c.states; float* CD = (float*)(c.ws + WS_MISC + MS_CD);
    WG_BAR();
    if (wave < 4) ssd_scalars(c, t0, g * 4 + wave, DT + wave * 128, ACS + wave * 128, lane);
    WG_BAR();
    {
        const int oct = tid & 63, seg = tid >> 6;
        const float* cw = c.in[I_CONVW] + c.L * 4096; const float* cb = c.in[I_CONVB] + c.L * 1024;
        if (oct < 16) { const int cc = 512 + g * 128 + 8 * oct;
            conv8<16>(c.PROJ + (size_t)t0 * PJ + O_XBC + cc, s0, seg * 16, cw, cb, cc, [&](int l, const float (&v)[8]) { *(LAS v4u*)(BL + l * 160 + 8 * oct) = pack8(v); });
        } else if (oct < 48) { const int o2 = oct - 16, h = o2 >> 3, cc = g * 256 + 8 * o2;
            const float aend = ACS[h * 128 + 127];
            conv8<16>(c.PROJ + (size_t)t0 * PJ + O_XBC + cc, s0, seg * 16, cw, cb, cc, [&](int l, const float (&v)[8]) {
                const float sc = DT[h * 128 + l] * __expf(aend - ACS[h * 128 + l]); float w[8];
#pragma unroll
                for (int j = 0; j < 8; ++j) w[j] = v[j] * sc;
                *(LAS v4u*)(XS + l * 288 + 8 * o2) = pack8(w); });
        }
    }
    WG_BAR();
    const int pi = wave >> 2, ni = wave & 3, r = lane & 31, hh = lane >> 5;
#pragma unroll 1
    for (int h = 0; h < 4; ++h) {
        f32x16 acc = zero16();
        mma<true, true>(acc, XS, 288, h * 64 + 32 * pi, BL, 160, 32 * ni, 128, lane);
        float* dst = STATES + ((size_t)(bc * 8 + g * 4 + h) * 64 + 32 * pi) * 128 + 32 * ni + r;
#pragma unroll
        for (int i = 0; i < 16; ++i) dst[(size_t)crow(i, hh) * 128] = acc[i];
    }
    if (tid < 4) CD[bc * 8 + g * 4 + tid] = __expf(ACS[tid * 128 + 127]);
}

__device__ __forceinline__ void ml_summary_unit(const MixCtx& c, int u, LAS unsigned char* lds, int wave, int lane) {
    const int h = u & 3, bc = u >> 2, t0 = bc * 128, tid = wave * 64 + lane;
    lf32 EE = (lf32)lds, NPART = (lf32)(lds + 512);
    lbf VS = (lbf)(lds + 2048), KS = (lbf)(lds + 2048 + 24576);
    float* CLOC = c.cloc; unsigned char* ms = c.ws + WS_MISC;
    WG_BAR();
    if (wave == 0) {
        const float ib = c.in[I_MIB][c.L * 4 + h], fb = c.in[I_MFB][c.L * 4 + h];
        const float li0 = c.SMALL[(size_t)(t0 + 2 * lane) * 16 + SM_MI + h] + ib, li1 = c.SMALL[(size_t)(t0 + 2 * lane + 1) * 16 + SM_MI + h] + ib;
        float b0 = logsigmoid_fast(c.SMALL[(size_t)(t0 + 2 * lane) * 16 + SM_MF + h] + fb), b1 = logsigmoid_fast(c.SMALL[(size_t)(t0 + 2 * lane + 1) * 16 + SM_MF + h] + fb);
        scan_add128(b0, b1, lane);
        const float gsum = shfl_f(b1, 63);
        const float w0 = gsum - b0 + li0, w1 = gsum - b1 + li1;
        const float ml = wave_max(fmaxf(w0, w1), lane);
        EE[2 * lane] = __expf(w0 - ml); EE[2 * lane + 1] = __expf(w1 - ml);
        if (lane == 0) { ((float*)(ms + MS_G))[u] = gsum; ((float*)(ms + MS_ML))[u] = ml; }
    }
    const int oct = tid & 7, r0 = tid >> 3;
    v4u vraw[2], kraw[2];
#pragma unroll
    for (int pass = 0; pass < 2; ++pass) { const bf16* row = c.PROJ + (size_t)(t0 + r0 + 64 * pass) * PJ + h * 64 + 8 * oct; vraw[pass] = *(const v4u*)(row + O_MV); kraw[pass] = *(const v4u*)(row + O_MK); }
    WG_BAR();
#pragma unroll
    for (int pass = 0; pass < 2; ++pass) { const int s = r0 + 64 * pass; float v[8], k[8]; unpack8(vraw[pass], v); unpack8(kraw[pass], k); const float e = EE[s];
#pragma unroll
        for (int j = 0; j < 8; ++j) { v[j] *= e; k[j] *= 0.125f; }
        *(LAS v4u*)(VS + s * 96 + 8 * oct) = pack8(v); *(LAS v4u*)(KS + s * 96 + 8 * oct) = pack8(k); }
    WG_BAR();
    if (wave < 4) {
        const int ei = wave >> 1, di = wave & 1, r = lane & 31, hh = lane >> 5;
        f32x16 acc = zero16();
        mma<true, true>(acc, VS, 96, 32 * ei, KS, 96, 32 * di, 128, lane);
        float* dst = CLOC + ((size_t)u * 64 + 32 * ei) * 64 + 32 * di + r;
#pragma unroll
        for (int i = 0; i < 16; ++i) dst[crow(i, hh) * 64] = acc[i];
    } else {
        const int part = wave - 4; float a = 0.f;
#pragma unroll 8
        for (int s = 32 * part; s < 32 * part + 32; ++s) a += EE[s] * bf2f(KS[s * 96 + lane]);
        NPART[part * 64 + lane] = a;
    }
    WG_BAR();
    if (wave == 4) ((float*)(ms + MS_NL))[(size_t)u * 64 + lane] = (NPART[lane] + NPART[64 + lane]) + (NPART[128 + lane] + NPART[192 + lane]);
}

__device__ __forceinline__ void scan_phase(const MixCtx& c, int G, int wave, int lane) {
    const int gt = blockIdx.x * NT + wave * 64 + lane, ngt = G * NT;
    const float* STATES = c.states; const float* CD = (const float*)(c.ws + WS_MISC + MS_CD);
    for (int e = gt; e < NB * 8 * 64 * 32; e += ngt) {
        const int n4 = e & 31, p = (e >> 5) & 63, hd = (e >> 11) & 7, b = e >> 14;
        const size_t base4 = ((size_t)((b * 16) * 8 + hd) * 64 + p) * 32 + n4;
        const f32x4* sp = (const f32x4*)STATES + base4; u32x2m* pp = (u32x2m*)c.prev + base4;
        f32x4 sv[16]; float cd[16];
#pragma unroll
        for (int ch = 0; ch < 16; ++ch) { sv[ch] = sp[(size_t)ch * 16384]; cd[ch] = CD[(b * 16 + ch) * 8 + hd]; }
        float z0 = 0.f; LAUNDER(z0); f32x4 run = {z0, z0, z0, z0};
#pragma unroll
        for (int ch = 0; ch < 16; ++ch) { pp[(size_t)ch * 16384] = (u32x2m){cvt2(run.x, run.y), cvt2(run.z, run.w)}; run = run * cd[ch] + sv[ch]; }
    }
    float* CLOC = c.cloc; unsigned char* ms = c.ws + WS_MISC;
    const float* Gs = (const float*)(ms + MS_G); const float* ML = (const float*)(ms + MS_ML); float* MP = (float*)(ms + MS_MP); float* NL = (float*)(ms + MS_NL);
    for (int e = gt; e < NB * 4 * 64 * 16 + NB * 4 * 16; e += ngt) {
        const bool isn = e >= NB * 4 * 64 * 16; const int e2 = isn ? e - NB * 4 * 64 * 16 : e;
        const int d4 = e2 & 15, er = isn ? 0 : (e2 >> 4) & 63, bh = isn ? (e2 >> 4) : (e2 >> 10), h = bh & 3, b = bh >> 2;
        const int u0 = (b * 16) * 4 + h;
        float gl[16], ml[16];
#pragma unroll
        for (int ch = 0; ch < 16; ++ch) { gl[ch] = Gs[u0 + 4 * ch]; ml[ch] = ML[u0 + 4 * ch]; }
        float z0 = 0.f; LAUNDER(z0); f32x4 run = {z0, z0, z0, z0}; float m = 0.f; f32x4 sv[16];
        if (!isn) {
            const f32x4* sp = (const f32x4*)(CLOC + ((size_t)u0 * 64 + er) * 64) + d4; u32x2m* cp = (u32x2m*)c.cprev + ((size_t)u0 * 64 + er) * 16 + d4;
#pragma unroll
            for (int ch = 0; ch < 16; ++ch) sv[ch] = sp[(size_t)ch * 4096];
#pragma unroll
            for (int ch = 0; ch < 16; ++ch) { const float mn = fmaxf(gl[ch] + m, ml[ch]), ap = __expf(gl[ch] + m - mn), al = __expf(ml[ch] - mn);
                cp[(size_t)ch * 4096] = (u32x2m){cvt2(run.x, run.y), cvt2(run.z, run.w)}; run = run * ap + sv[ch] * al; m = mn; }
        } else {
            f32x4* sp = (f32x4*)(NL + (size_t)u0 * 64) + d4;
#pragma unroll
            for (int ch = 0; ch < 16; ++ch) sv[ch] = sp[ch * 64];
#pragma unroll
            for (int ch = 0; ch < 16; ++ch) { const float mn = fmaxf(gl[ch] + m, ml[ch]), ap = __expf(gl[ch] + m - mn), al = __expf(ml[ch] - mn);
                sp[ch * 64] = run; if (d4 == 0) MP[u0 + 4 * ch] = m; run = run * ap + sv[ch] * al; m = mn; }
        }
    }
}

template <int VAR>
__device__ __forceinline__ void ssd_group(const MixCtx& c, int bc, int g, LAS unsigned char* lds, int wave, int lane_in, unsigned (&gp)[4][8], float& ssq) {
    const int t0 = bc * 128, s0 = (bc & 15) * 128;
    lf32 DT = (lf32)lds, ACS = (lf32)(lds + 2048);
    lbf CL = (lbf)(lds + 4096), BL = (lbf)(lds + 4096 + 34816), PV = (lbf)(lds + 4096 + 2 * 34816), XD = PV;
    const float* cw = c.in[I_CONVW] + c.L * 4096; const float* cb = c.in[I_CONVB] + c.L * 1024;
    {
        int lane = lane_in; LAUNDER(lane); const int tid = wave * 64 + lane, r = lane & 31, hh = lane >> 5;
        const int li = wave >> 1, ph = wave & 1, l = 32 * li + r;
        WG_BAR();
        {
            const v4u* src = (const v4u*)(c.prev + (size_t)(bc * 8 + g * 4) * 8192);
            v4u pvr[8];
#pragma unroll
            for (int k = 0; k < 8; ++k) pvr[k] = src[tid + 512 * k];
            if (wave < 4) ssd_scalars(c, t0, g * 4 + wave, DT + wave * 128, ACS + wave * 128, lane);
            {
                const int oct = tid & 31, seg = tid >> 5; const int cc = 512 + (oct >> 4) * 256 + g * 128 + 8 * (oct & 15);
                lbf dstm = (oct < 16) ? BL : CL;
                conv8<8>(c.PROJ + (size_t)t0 * PJ + O_XBC + cc, s0, seg * 8, cw, cb, cc, [&](int l2, const float (&v)[8]) { *(LAS v4u*)(dstm + l2 * 136 + 8 * (oct & 15)) = pack8(v); });
            }
#pragma unroll
            for (int k = 0; k < 8; ++k) { const int e = tid + 512 * k, pr = e >> 4, n8 = e & 15; *(LAS v4u*)(PV + pr * 136 + 8 * n8) = pvr[k]; }
        }
        WG_BAR();
        f32x16 ag[4];
#pragma unroll
        for (int h = 0; h < 4; ++h) { ag[h] = zero16();
            if (VAR >= 2) mma<false, false>(ag[h], PV, 136, h * 64 + 32 * ph, CL, 136, 32 * li, 128, lane);
            const float el = __expf(ACS[h * 128 + l]);
#pragma unroll
            for (int i = 0; i < 16; ++i) ag[h][i] *= el; }
        WG_BAR();
        if (VAR >= 3) {
            const int oct = tid & 31, seg = tid >> 5, h = oct >> 3, cc = g * 256 + 8 * oct;
            conv8<8>(c.PROJ + (size_t)t0 * PJ + O_XBC + cc, s0, seg * 8, cw, cb, cc, [&](int l2, const float (&v)[8]) {
                const float dt = DT[h * 128 + l2]; float w[8];
#pragma unroll
                for (int j = 0; j < 8; ++j) w[j] = v[j] * dt;
                *(LAS v4u*)(XD + l2 * 288 + 8 * oct) = pack8(w); });
        }
        WG_BAR();
#pragma unroll 1
        for (int si = 0; si <= (VAR >= 4 ? li : -1); ++si) {
            f32x16 cbT = zero16();
            mma<false, false>(cbT, BL, 136, 32 * si, CL, 136, 32 * li, 128, lane);
#pragma unroll
            for (int h = 0; h < 4; ++h) {
                const float al = ACS[h * 128 + l]; float p[16];
                float as_[16];
#pragma unroll
                for (int i = 0; i < 16; ++i) as_[i] = ACS[h * 128 + 32 * si + crow(i, hh)];
#pragma unroll
                for (int i = 0; i < 16; ++i) { const int s = 32 * si + crow(i, hh); const float w = cbT[i] * __expf(fminf(al - as_[i], 0.f)); p[i] = (si < li || s <= l) ? w : 0.f; }
#pragma unroll
                for (int s2 = 0; s2 < 2; ++s2) {
                    const v4u pw = {cvt2(p[8 * s2], p[8 * s2 + 1]), cvt2(p[8 * s2 + 2], p[8 * s2 + 3]), cvt2(p[8 * s2 + 4], p[8 * s2 + 5]), cvt2(p[8 * s2 + 6], p[8 * s2 + 7])};
                    ag[h] = __builtin_amdgcn_mfma_f32_32x32x16_bf16(frag_tp(XD, 288, 32 * si + 16 * s2, h * 64 + 32 * ph, lane), __builtin_bit_cast(bf16x8, pw), ag[h], 0, 0, 0);
                }
            }
        }
#pragma unroll
        for (int h = 0; h < 4; ++h) {
            const float dsk = c.in[I_SSDD][c.L * 8 + g * 4 + h] / fmaxf(DT[h * 128 + l], 1e-20f);
            lbf xrow = XD + l * 288 + h * 64 + 32 * ph + 4 * hh;
#pragma unroll
            for (int gq = 0; gq < 4; ++gq) { const u32x2m xw = *(const LAS u32x2m*)(xrow + 8 * gq);
                ag[h][4 * gq] += __uint_as_float(xw.x << 16) * dsk; ag[h][4 * gq + 1] += __uint_as_float(xw.x & 0xffff0000u) * dsk;
                ag[h][4 * gq + 2] += __uint_as_float(xw.y << 16) * dsk; ag[h][4 * gq + 3] += __uint_as_float(xw.y & 0xffff0000u) * dsk; }
        }
        WG_BAR();
        lbf ZG = (lbf)(lds + 4096);
        {
            v4u zv[8];
#pragma unroll
            for (int k = 0; k < 8; ++k) { const int e = tid + 512 * k; zv[k] = *(const v4u*)(c.PROJ + (size_t)(t0 + (e >> 5)) * PJ + O_Z + g * 256 + 8 * (e & 31)); }
#pragma unroll
            for (int k = 0; k < 8; ++k) { const int e = tid + 512 * k; LAS u32x2m* d = (LAS u32x2m*)(ZG + (e >> 5) * 260 + 8 * (e & 31)); d[0] = (u32x2m){zv[k].x, zv[k].y}; d[1] = (u32x2m){zv[k].z, zv[k].w}; }
        }
        WG_BAR();
#pragma unroll
        for (int h = 0; h < 4; ++h) { lbf zrow = ZG + l * 260 + h * 64 + 32 * ph + 4 * hh;
#pragma unroll
            for (int gq = 0; gq < 4; ++gq) { const u32x2m zw = *(const LAS u32x2m*)(zrow + 8 * gq);
                const float z4[4] = {__uint_as_float(zw.x << 16), __uint_as_float(zw.x & 0xffff0000u), __uint_as_float(zw.y << 16), __uint_as_float(zw.y & 0xffff0000u)}; float o4[4];
#pragma unroll
                for (int k = 0; k < 4; ++k) { o4[k] = ag[h][4 * gq + k] * z4[k] * __builtin_amdgcn_rcpf(1.0f + __expf(-z4[k])); ssq += o4[k] * o4[k]; }
                gp[h][2 * gq] = cvt2(o4[0], o4[1]); gp[h][2 * gq + 1] = cvt2(o4[2], o4[3]); } }
    }
}
template <int VAR = 9>
__device__ __forceinline__ void ssd_out_unit(const MixCtx& c, int bc, LAS unsigned char* lds, int wave, int lane_in) {
    const int t0 = bc * 128;
    lf32 SQ = (lf32)lds;
    lbf ZT = (lbf)(lds + 4096);
    unsigned g0[4][8], g1[4][8]; float ss = 0.f;
#pragma unroll
    for (int a_ = 0; a_ < 4; ++a_)
#pragma unroll
        for (int b_ = 0; b_ < 8; ++b_) { g0[a_][b_] = 0u; g1[a_][b_] = 0u; }
#pragma unroll 1
    for (int g = 0; g < 2; ++g) {
        unsigned gp[4][8];
        ssd_group<VAR>(c, bc, g, lds, wave, lane_in, gp, ss);
#pragma unroll
        for (int a_ = 0; a_ < 4; ++a_)
#pragma unroll
            for (int b_ = 0; b_ < 8; ++b_) { if (g == 0) g0[a_][b_] = gp[a_][b_]; else g1[a_][b_] = gp[a_][b_]; }
    }
    if (VAR < 5) return;
    int lane = lane_in; LAUNDER(lane); const int tid = wave * 64 + lane, r = lane & 31, hh = lane >> 5;
    const int li = wave >> 1, ph = wave & 1, l = 32 * li + r;
    (void)ss; (void)SQ;
    WG_BAR();
#pragma unroll
    for (int h = 0; h < 8; ++h) { lbf orow = ZT + l * 516 + h * 64 + 32 * ph + 4 * hh;
#pragma unroll
        for (int gq = 0; gq < 4; ++gq) { const unsigned p0 = (h < 4) ? g0[h & 3][2 * gq] : g1[h & 3][2 * gq], p1 = (h < 4) ? g0[h & 3][2 * gq + 1] : g1[h & 3][2 * gq + 1];
            *(LAS u32x2m*)(orow + 8 * gq) = (u32x2m){p0, p1}; } }
    WG_BAR();
    {
        const float* nw = c.in[I_SSDNW] + c.L * 512;
        float wv[8]; { const f32x4 a = *(const f32x4*)(nw + 8 * lane), b = *(const f32x4*)(nw + 8 * lane + 4); wv[0] = a.x; wv[1] = a.y; wv[2] = a.z; wv[3] = a.w; wv[4] = b.x; wv[5] = b.y; wv[6] = b.z; wv[7] = b.w; }
#pragma unroll 4
        for (int k = 0; k < 16; ++k) { const int row = wave * 16 + k; const LAS u32x2m* sp = (const LAS u32x2m*)(ZT + row * 516 + 8 * lane);
            const u32x2m a = sp[0], b = sp[1]; float v[8]; unpack8((v4u){a.x, a.y, b.x, b.y}, v); float s2 = 0.f;
#pragma unroll
            for (int j2 = 0; j2 < 8; ++j2) s2 += v[j2] * v[j2];
            const float rs = rsqrtf(wave_sum_l(s2, lane) * (1.f / 512.f) + EPS);
#pragma unroll
            for (int j2 = 0; j2 < 8; ++j2) v[j2] *= rs * wv[j2];
            *(v4u*)(c.MIX + (size_t)(t0 + row) * 1024 + 8 * lane) = pack8(v); }
    }
}

__device__ __forceinline__ void ml_out_unit(const MixCtx& c, int u, LAS unsigned char* lds, int wave, int lane) {
    const int h = u & 3, bc = u >> 2, t0 = bc * 128, tid = wave * 64 + lane;
    lf32 RM = (lf32)lds, U = (lf32)(lds + 512), MT = (lf32)(lds + 1024), WI = (lf32)(lds + 1536), DEN = (lf32)(lds + 2048), NP = (lf32)(lds + 2560);
    lbf Q = (lbf)(lds + 4096), Kk = (lbf)(lds + 22528), VS = (lbf)(lds + 40960), CP = (lbf)(lds + 65536), AM = (lbf)(lds + 74752);
    lf32 HBf = (lf32)(lds + 4096);
    const unsigned char* ms = c.ws + WS_MISC;
    WG_BAR();
    if (wave == 0) {
        const float ib = c.in[I_MIB][c.L * 4 + h], fb = c.in[I_MFB][c.L * 4 + h];
        const float li0 = c.SMALL[(size_t)(t0 + 2 * lane) * 16 + SM_MI + h] + ib, li1 = c.SMALL[(size_t)(t0 + 2 * lane + 1) * 16 + SM_MI + h] + ib;
        float b0 = logsigmoid_fast(c.SMALL[(size_t)(t0 + 2 * lane) * 16 + SM_MF + h] + fb), b1 = logsigmoid_fast(c.SMALL[(size_t)(t0 + 2 * lane + 1) * 16 + SM_MF + h] + fb);
        scan_add128(b0, b1, lane);
        const float u0 = li0 - b0, u1 = li1 - b1; float p0 = u0, p1 = u1; scan_max128(p0, p1, lane);
        const float mp = ((const float*)(ms + MS_MP))[u];
        const float in0 = b0 + mp, in1 = b1 + mp, mt0 = fmaxf(in0, b0 + p0), mt1 = fmaxf(in1, b1 + p1);
        U[2 * lane] = u0; U[2 * lane + 1] = u1; RM[2 * lane] = b0 - mt0; RM[2 * lane + 1] = b1 - mt1; MT[2 * lane] = mt0; MT[2 * lane + 1] = mt1;
        WI[2 * lane] = __expf(in0 - mt0); WI[2 * lane + 1] = __expf(in1 - mt1);
        NP[lane] = ((const float*)(ms + MS_NL))[(size_t)u * 64 + lane];
    }
    {
        const int oct = tid & 7, r0 = tid >> 3;
#pragma unroll
        for (int pass = 0; pass < 2; ++pass) { const int s = r0 + 64 * pass; const bf16* row = c.PROJ + (size_t)(t0 + s) * PJ + h * 64 + 8 * oct;
            *(LAS v4u*)(Q + s * 72 + 8 * oct) = *(const v4u*)(row + O_MQ);
            float k[8]; unpack8(*(const v4u*)(row + O_MK), k);
            *(LAS v4u*)(Kk + s * 72 + 8 * oct) = (v4u){cvt2(k[0] * 0.125f, k[1] * 0.125f), cvt2(k[2] * 0.125f, k[3] * 0.125f), cvt2(k[4] * 0.125f, k[5] * 0.125f), cvt2(k[6] * 0.125f, k[7] * 0.125f)};
            *(LAS v4u*)(VS + s * 96 + 8 * oct) = *(const v4u*)(row + O_MV); }
        *(LAS v4u*)(CP + (tid >> 3) * 72 + 8 * (tid & 7)) = ((const v4u*)(c.cprev + (size_t)u * 4096))[tid];
    }
    WG_BAR();
    const int r = lane & 31, hh = lane >> 5;
#pragma unroll
    for (int q = 0; q < 2; ++q) { const int id = wave + 8 * q;
        if (id < 10) { int li = 0, si = 0; { int rem = id; for (li = 0; li < 4; ++li) { if (rem <= li) { si = rem; break; } rem -= li + 1; } }
            f32x16 acc = zero16();
            mma<false, false>(acc, Q, 72, 32 * li, Kk, 72, 32 * si, 64, lane);
            const int scol = 32 * si + r; const float us = U[scol]; float rm[16];
#pragma unroll
            for (int i = 0; i < 16; ++i) rm[i] = RM[32 * li + crow(i, hh)];
#pragma unroll
            for (int i = 0; i < 16; ++i) { const int l = 32 * li + crow(i, hh); const float w = acc[i] * __expf(fminf(rm[i] + us, 0.f)); AM[l * 136 + scol] = f2bf((scol <= l) ? w : 0.f); } } }
    WG_BAR();
    {
        const int l = tid >> 2, part = tid & 3; float a = 0.f;
        if (32 * part <= l) {
#pragma unroll
            for (int k = 0; k < 4; ++k) { float v[8]; unpack8(*(const LAS v4u*)(AM + l * 136 + 32 * part + 8 * k), v);
#pragma unroll
                for (int j = 0; j < 8; ++j) a += (32 * part + 8 * k + j <= l) ? v[j] : 0.f; } }
        float qn = 0.f;
#pragma unroll
        for (int k = 0; k < 2; ++k) { float v[8]; unpack8(*(const LAS v4u*)(Q + l * 72 + 16 * part + 8 * k), v);
#pragma unroll
            for (int j = 0; j < 8; ++j) qn += v[j] * NP[16 * part + 8 * k + j]; }
        a += WI[l] * qn; a += shfl_f(a, lane ^ 1); a += shfl_f(a, lane ^ 2);
        if (part == 0) DEN[l] = fmaxf(fabsf(a), __expf(-MT[l]));
    }
    WG_BAR();
    {
        const int li = wave >> 1, ei = wave & 1;
        f32x16 acc = zero16();
        mma<false, false>(acc, Q, 72, 32 * li, CP, 72, 32 * ei, 64, lane);
#pragma unroll
        for (int i = 0; i < 16; ++i) acc[i] *= WI[32 * li + crow(i, hh)];
        mma<false, true>(acc, AM, 136, 32 * li, VS, 96, 32 * ei, 32 * (li + 1), lane);
        WG_BAR();
#pragma unroll
        for (int i = 0; i < 16; ++i) { const int l = 32 * li + crow(i, hh); HBf[l * 68 + 32 * ei + r] = acc[i] / DEN[l]; }
    }
    WG_BAR();
    {
        const int l = tid >> 2, part = tid & 3; const float* nw = c.in[I_MNW] + c.L * 256 + h * 64 + 16 * part;
        float v[16]; float s = 0.f;
#pragma unroll
        for (int k = 0; k < 4; ++k) { const f32x4 x = *(const LAS f32x4*)(HBf + l * 68 + 16 * part + 4 * k); v[4 * k] = x.x; v[4 * k + 1] = x.y; v[4 * k + 2] = x.z; v[4 * k + 3] = x.w; s += (x.x * x.x + x.y * x.y) + (x.z * x.z + x.w * x.w); }
        s += shfl_f(s, lane ^ 1); s += shfl_f(s, lane ^ 2);
        const float rs = rsqrtf(s * (1.f / 64.f) + EPS);
        const bf16* orow = c.PROJ + (size_t)(t0 + l) * PJ + O_MO + h * 64 + 16 * part; bf16* dst = c.MIX + (size_t)(t0 + l) * 1024 + 768 + h * 64 + 16 * part;
#pragma unroll
        for (int k = 0; k < 2; ++k) { float o[8]; unpack8(*(const v4u*)(orow + 8 * k), o); float y[8];
#pragma unroll
            for (int j = 0; j < 8; ++j) y[j] = __builtin_amdgcn_rcpf(1.0f + __expf(-o[j])) * v[8 * k + j] * rs * nw[8 * k + j];
            *(v4u*)(dst + 8 * k) = (v4u){cvt2(y[0], y[1]), cvt2(y[2], y[3]), cvt2(y[4], y[5]), cvt2(y[6], y[7])}; }
    }
}

typedef unsigned u32x2p __attribute__((ext_vector_type(2)));
__device__ __forceinline__ float xhalf_max(float v) { const u32x2p r = __builtin_amdgcn_permlane32_swap(__float_as_uint(v), __float_as_uint(v), false, false); return fmaxf(__uint_as_float(r.x), __uint_as_float(r.y)); }
__device__ __forceinline__ float xhalf_sum(float v) { const u32x2p r = __builtin_amdgcn_permlane32_swap(__float_as_uint(v), __float_as_uint(v), false, false); return __uint_as_float(r.x) + __uint_as_float(r.y); }
struct AttnTile { f32x16 s; bool far; };
__device__ __forceinline__ void attn_qk(AttnTile& t, lbf KS, int kt, int m, const bf16x8 (&qf)[2], int lane) {
    lbf kp = KS + (kt * 32 + (lane & 31)) * 72 + m * 32 + 8 * (lane >> 5);
    t.s = zero16();
    t.s = __builtin_amdgcn_mfma_f32_32x32x16_bf16(*(const LAS bf16x8*)kp, qf[0], t.s, 0, 0, 0);
    t.s = __builtin_amdgcn_mfma_f32_32x32x16_bf16(*(const LAS bf16x8*)(kp + 16), qf[1], t.s, 0, 0, 0);
}
__device__ __forceinline__ float attn_tmax(AttnTile& t, float c1, lf32 RL, int qpos, int k0, int hh, bool diag) {
    if (t.far) { float mt = t.s[0];
#pragma unroll
        for (int i = 1; i < 16; ++i) mt = fmaxf(mt, t.s[i]);
        return mt * c1 + RL[64]; }
    float mt = -1e30f;
    lf32 rb = RL + (191 - qpos + k0 + 4 * hh);
    float bias[16];
#pragma unroll
    for (int i = 0; i < 16; ++i) bias[i] = rb[(i & 3) + 8 * (i >> 2)];
    if (diag) {
#pragma unroll
        for (int i = 0; i < 16; ++i) { const float v = (k0 + crow(i, hh) <= qpos) ? t.s[i] * c1 + bias[i] : -1e30f; t.s[i] = v; mt = fmaxf(mt, v); }
    } else {
#pragma unroll
        for (int i = 0; i < 16; ++i) { const float v = t.s[i] * c1 + bias[i]; t.s[i] = v; mt = fmaxf(mt, v); }
    }
    return mt;
}
__device__ __forceinline__ float attn_probs(AttnTile& t, float c1, lf32 LUT, float mn) {
    float ps = 0.f;
    if (t.far) { const float cbm = LUT[64] - mn;
#pragma unroll
        for (int i = 0; i < 16; ++i) { t.s[i] = __builtin_amdgcn_exp2f(t.s[i] * c1 + cbm); ps += t.s[i]; }
    } else {
#pragma unroll
        for (int i = 0; i < 16; ++i) { t.s[i] = __builtin_amdgcn_exp2f(t.s[i] - mn); ps += t.s[i]; }
    }
    return ps;
}
__device__ __forceinline__ void attn_pv(const AttnTile& t, lbf VS, int krow0, f32x16& o0, f32x16& o1, int lane) {
#pragma unroll
    for (int s2 = 0; s2 < 2; ++s2) {
        const v4u pw = {cvt2(t.s[8 * s2], t.s[8 * s2 + 1]), cvt2(t.s[8 * s2 + 2], t.s[8 * s2 + 3]), cvt2(t.s[8 * s2 + 4], t.s[8 * s2 + 5]), cvt2(t.s[8 * s2 + 6], t.s[8 * s2 + 7])};
        const bf16x8 pf = __builtin_bit_cast(bf16x8, pw);
        o0 = __builtin_amdgcn_mfma_f32_32x32x16_bf16(frag_tp(VS, 96, krow0 + 16 * s2, 0, lane), pf, o0, 0, 0, 0);
        o1 = __builtin_amdgcn_mfma_f32_32x32x16_bf16(frag_tp(VS, 96, krow0 + 16 * s2, 32, lane), pf, o1, 0, 0, 0);
    }
}
__device__ __forceinline__ void attn_unit(const MixCtx& c, int b, int h, int qb, float lam, float lam_init, LAS unsigned char* lds, int wave, int lane) {
    constexpr float LOG2E = 1.4426950408889634f;
    constexpr int STAGE = 18432 + 24576;
    const int tid = wave * 64 + lane;
    lf32 LUT = (lf32)lds;
    lf32 OB = (lf32)(lds + 1024);
    const int m = wave >> 2, qs = wave & 3, r = lane & 31, hh = lane >> 5;
    const int q0 = qb * 128 + qs * 32, qpos = q0 + r;
    WG_BAR();
    if (tid < 224) { const int d = 191 - tid; LUT[tid] = c.in[I_RELB][T5_BUCKET[d < 0 ? 0 : (d < 127 ? d : 127)] * 4 + h] * LOG2E; }
    bf16x8 qf[2];
    { const bf16* qp = c.PROJ + ((size_t)b * S + qpos) * PJ + O_DQ + h * 64 + m * 32 + 8 * hh; qf[0] = *(const bf16x8*)qp; qf[1] = *(const bf16x8*)(qp + 16); }
    f32x16 o0 = zero16(), o1 = zero16(); float mrun = -1e30f, lrun = 0.f;
    const float c1 = 0.17677669529663687f * LOG2E;
    const int soct = tid & 7, sr0 = tid >> 3;
    const bf16* kvbase = c.PROJ + ((size_t)b * S + sr0) * PJ + h * 64 + 8 * soct;
    v4u kreg[2], vreg[2];
#define ATT_LOAD(kb_) do { _Pragma("unroll") for (int pass = 0; pass < 2; ++pass) { const bf16* row = kvbase + (size_t)((kb_) * 128 + 64 * pass) * PJ; kreg[pass] = *(const v4u*)(row + O_DK); vreg[pass] = *(const v4u*)(row + O_DV); } } while (0)
#define ATT_STORE(buf_) do { LAS unsigned char* sb_ = lds + 1024 + (buf_) * STAGE; _Pragma("unroll") for (int pass = 0; pass < 2; ++pass) { const int key = sr0 + 64 * pass; \
        *(LAS v4u*)((lbf)sb_ + key * 72 + 8 * soct) = kreg[pass]; *(LAS v4u*)((lbf)(sb_ + 18432) + key * 96 + 8 * soct) = vreg[pass]; } } while (0)
    ATT_LOAD(0);
    ATT_STORE(0);
    if (qb > 0) ATT_LOAD(1);
    WG_BAR();
#pragma unroll 1
    for (int kb = 0; kb <= qb; ++kb) {
        lbf KS = (lbf)(lds + 1024 + (kb & 1) * STAGE), VS = (lbf)(lds + 1024 + (kb & 1) * STAGE + 18432);
        const int ntile = (kb < qb) ? 4 : qs + 1;
        int kt = 0;
#pragma unroll 1
        for (; kt + 1 < ntile; kt += 2) {
            const int k0 = kb * 128 + kt * 32;
            AttnTile ta, tb; ta.far = (q0 - k0 >= 144); tb.far = (q0 - (k0 + 32) >= 144);
            attn_qk(ta, KS, kt, m, qf, lane); attn_qk(tb, KS, kt + 1, m, qf, lane);
            const float mt = xhalf_max(fmaxf(attn_tmax(ta, c1, LUT, qpos, k0, hh, k0 == q0), attn_tmax(tb, c1, LUT, qpos, k0 + 32, hh, k0 + 32 == q0)));
            const float mn = fmaxf(mrun, mt);
            if (__any(mn > mrun)) { const float al = __builtin_amdgcn_exp2f(mrun - mn); lrun *= al;
#pragma unroll
                for (int i = 0; i < 16; ++i) { o0[i] *= al; o1[i] *= al; } }
            mrun = mn;
            lrun += attn_probs(ta, c1, LUT, mn) + attn_probs(tb, c1, LUT, mn);
            attn_pv(ta, VS, kt * 32, o0, o1, lane); attn_pv(tb, VS, kt * 32 + 32, o0, o1, lane);
        }
        if (kt < ntile) {
            const int k0 = kb * 128 + kt * 32;
            AttnTile ta; ta.far = (q0 - k0 >= 144);
            attn_qk(ta, KS, kt, m, qf, lane);
            const float mt = xhalf_max(attn_tmax(ta, c1, LUT, qpos, k0, hh, k0 == q0));
            const float mn = fmaxf(mrun, mt);
            if (__any(mn > mrun)) { const float al = __builtin_amdgcn_exp2f(mrun - mn); lrun *= al;
#pragma unroll
                for (int i = 0; i < 16; ++i) { o0[i] *= al; o1[i] *= al; } }
            mrun = mn;
            lrun += attn_probs(ta, c1, LUT, mn);
            attn_pv(ta, VS, kt * 32, o0, o1, lane);
        }
        if (kb < qb) {
            ATT_STORE((kb + 1) & 1);
            if (kb + 1 < qb) ATT_LOAD(kb + 2);
        }
        WG_BAR();
    }
#undef ATT_LOAD
#undef ATT_STORE
    lrun = xhalf_sum(lrun);
    { const float inv = 1.f / lrun; lf32 ob = OB + (size_t)(m * 128 + qs * 32 + r) * 68;
#pragma unroll
      for (int i = 0; i < 16; ++i) { ob[crow(i, hh)] = o0[i] * inv; ob[32 + crow(i, hh)] = o1[i] * inv; } }
    WG_BAR();
    {
        const int q = tid >> 2, part = tid & 3; const float* nw = c.in[I_DNW] + c.L * 64 + 16 * part;
        float o[16]; float ss = 0.f;
#pragma unroll
        for (int k = 0; k < 4; ++k) { const f32x4 x0 = *(const LAS f32x4*)(OB + (size_t)q * 68 + 16 * part + 4 * k), x1 = *(const LAS f32x4*)(OB + (size_t)(128 + q) * 68 + 16 * part + 4 * k);
            const f32x4 d = x0 - x1 * lam; o[4 * k] = d.x; o[4 * k + 1] = d.y; o[4 * k + 2] = d.z; o[4 * k + 3] = d.w; ss += (d.x * d.x + d.y * d.y) + (d.z * d.z + d.w * d.w); }
        ss += shfl_f(ss, lane ^ 1); ss += shfl_f(ss, lane ^ 2);
        const float rs = rsqrtf(ss * (1.f / 64.f) + EPS) * (1.f - lam_init);
        bf16* dst = c.MIX + ((size_t)b * S + qb * 128 + q) * 1024 + 512 + h * 64 + 16 * part;
#pragma unroll
        for (int k = 0; k < 2; ++k) *(v4u*)(dst + 8 * k) = (v4u){cvt2(o[8 * k] * rs * nw[8 * k], o[8 * k + 1] * rs * nw[8 * k + 1]), cvt2(o[8 * k + 2] * rs * nw[8 * k + 2], o[8 * k + 3] * rs * nw[8 * k + 3]),
                                                                 cvt2(o[8 * k + 4] * rs * nw[8 * k + 4], o[8 * k + 5] * rs * nw[8 * k + 5]), cvt2(o[8 * k + 6] * rs * nw[8 * k + 6], o[8 * k + 7] * rs * nw[8 * k + 7])};
    }
}

__device__ __forceinline__ float attn3_tmax(AttnTile& t, lf32 RLb, int qpos, int k0, int hh, bool diag) {
    float mt;
    if (t.far) { mt = t.s[0];
#pragma unroll
        for (int i = 1; i < 16; ++i) mt = fmaxf(mt, t.s[i]);
        return mt; }
    lf32 rb = RLb + (191 - qpos + k0 + 4 * hh);
    float bias[16];
#pragma unroll
    for (int i = 0; i < 16; ++i) bias[i] = rb[(i & 3) + 8 * (i >> 2)];
    mt = -1e30f;
    if (diag) {
#pragma unroll
        for (int i = 0; i < 16; ++i) { const float v = (k0 + crow(i, hh) <= qpos) ? t.s[i] + bias[i] : -1e30f; t.s[i] = v; mt = fmaxf(mt, v); }
    } else {
#pragma unroll
        for (int i = 0; i < 16; ++i) { const float v = t.s[i] + bias[i]; t.s[i] = v; mt = fmaxf(mt, v); }
    }
    return mt;
}
__device__ __forceinline__ float attn3_probs(AttnTile& t) {
    float ps = 0.f;
#pragma unroll
    for (int i = 0; i < 16; ++i) { t.s[i] = __builtin_amdgcn_exp2f(t.s[i]); ps += t.s[i]; }
    return ps;
}
__device__ __forceinline__ void attn3_unit(const MixCtx& c, int b, int h, int qb, float lam, float lam_init, LAS unsigned char* lds, int wave, int lane) {
    constexpr float LOG2E = 1.4426950408889634f, THR = 6.0f;
    constexpr int STAGE = 18432 + 24576;
    const int tid = wave * 64 + lane;
    lf32 LUT = (lf32)lds;
    lf32 OB = (lf32)(lds + 1024);
    const int m = wave >> 2, qs = wave & 3, r = lane & 31, hh = lane >> 5;
    const int q0 = qb * 128 + qs * 32, qpos = q0 + r;
    const float cb = c.in[I_RELB][31 * 4 + h] * LOG2E;
    WG_BAR();
    if (tid < 224) { const int d = 191 - tid; LUT[tid] = c.in[I_RELB][T5_BUCKET[d < 0 ? 0 : (d < 127 ? d : 127)] * 4 + h] * LOG2E - cb; }
    bf16x8 qf[2];
    { const bf16* qp = c.PROJ + ((size_t)b * S + qpos) * PJ + O_DQ + h * 64 + m * 32 + 8 * hh; qf[0] = *(const bf16x8*)qp; qf[1] = *(const bf16x8*)(qp + 16); }
    f32x16 o0 = zero16(), o1 = zero16(), negm; float lrun = 0.f;
#pragma unroll
    for (int i = 0; i < 16; ++i) negm[i] = cb;
    const int soct = tid & 7, sr0 = tid >> 3;
    const bf16* kvbase = c.PROJ + ((size_t)b * S + sr0) * PJ + h * 64 + 8 * soct;
    v4u kreg[2], vreg[2];
#define ATT_LOAD(kb_) do { _Pragma("unroll") for (int pass = 0; pass < 2; ++pass) { const bf16* row = kvbase + (size_t)((kb_) * 128 + 64 * pass) * PJ; kreg[pass] = *(const v4u*)(row + O_DK); vreg[pass] = *(const v4u*)(row + O_DV); } } while (0)
#define ATT_STORE(buf_) do { LAS unsigned char* sb_ = lds + 1024 + (buf_) * STAGE; _Pragma("unroll") for (int pass = 0; pass < 2; ++pass) { const int key = sr0 + 64 * pass; \
        *(LAS v4u*)((lbf)sb_ + key * 72 + 8 * soct) = kreg[pass]; *(LAS v4u*)((lbf)(sb_ + 18432) + key * 96 + 8 * soct) = vreg[pass]; } } while (0)
#define ATT_QK(t_, kt_) do { lbf kp_ = KS + ((kt_) * 32 + r) * 72 + m * 32 + 8 * hh; \
        (t_).s = __builtin_amdgcn_mfma_f32_32x32x16_bf16(*(const LAS bf16x8*)kp_, qf[0], negm, 0, 0, 0); \
        (t_).s = __builtin_amdgcn_mfma_f32_32x32x16_bf16(*(const LAS bf16x8*)(kp_ + 16), qf[1], (t_).s, 0, 0, 0); } while (0)
    ATT_LOAD(0);
    ATT_STORE(0);
    if (qb > 0) ATT_LOAD(1);
    WG_BAR();
#pragma unroll 1
    for (int kb = 0; kb <= qb; ++kb) {
        lbf KS = (lbf)(lds + 1024 + (kb & 1) * STAGE), VS = (lbf)(lds + 1024 + (kb & 1) * STAGE + 18432);
        const int ntile = (kb < qb) ? 4 : qs + 1;
        int kt = 0;
#pragma unroll 1
        for (; kt + 1 < ntile; kt += 2) {
            const int k0 = kb * 128 + kt * 32;
            AttnTile ta, tb; ta.far = (q0 - k0 >= 144); tb.far = (q0 - (k0 + 32) >= 144);
            ATT_QK(ta, kt); ATT_QK(tb, kt + 1);
            const float tm = xhalf_max(fmaxf(attn3_tmax(ta, LUT, qpos, k0, hh, k0 == q0), attn3_tmax(tb, LUT, qpos, k0 + 32, hh, k0 + 32 == q0)));
            if (__any(tm > THR)) { const float d = (tm > THR) ? tm : 0.f, al = __builtin_amdgcn_exp2f(-d); lrun *= al;
#pragma unroll
                for (int i = 0; i < 16; ++i) { o0[i] *= al; o1[i] *= al; negm[i] -= d; ta.s[i] -= d; tb.s[i] -= d; } }
            lrun += attn3_probs(ta) + attn3_probs(tb);
            attn_pv(ta, VS, kt * 32, o0, o1, lane); attn_pv(tb, VS, kt * 32 + 32, o0, o1, lane);
        }
        if (kt < ntile) {
            const int k0 = kb * 128 + kt * 32;
            AttnTile ta; ta.far = (q0 - k0 >= 144);
            ATT_QK(ta, kt);
            const float tm = xhalf_max(attn3_tmax(ta, LUT, qpos, k0, hh, k0 == q0));
            if (__any(tm > THR)) { const float d = (tm > THR) ? tm : 0.f, al = __builtin_amdgcn_exp2f(-d); lrun *= al;
#pragma unroll
                for (int i = 0; i < 16; ++i) { o0[i] *= al; o1[i] *= al; negm[i] -= d; ta.s[i] -= d; } }
            lrun += attn3_probs(ta);
            attn_pv(ta, VS, kt * 32, o0, o1, lane);
        }
        if (kb < qb) {
            ATT_STORE((kb + 1) & 1);
            if (kb + 1 < qb) ATT_LOAD(kb + 2);
        }
        WG_BAR();
    }
#undef ATT_LOAD
#undef ATT_STORE
#undef ATT_QK
    lrun = xhalf_sum(lrun);
    { const float inv = 1.f / lrun; lf32 ob = OB + (size_t)(m * 128 + qs * 32 + r) * 68;
#pragma unroll
      for (int i = 0; i < 16; ++i) { ob[crow(i, hh)] = o0[i] * inv; ob[32 + crow(i, hh)] = o1[i] * inv; } }
    WG_BAR();
    {
        const int q = tid >> 2, part = tid & 3; const float* nw = c.in[I_DNW] + c.L * 64 + 16 * part;
        float o[16]; float ss = 0.f;
#pragma unroll
        for (int k = 0; k < 4; ++k) { const f32x4 x0 = *(const LAS f32x4*)(OB + (size_t)q * 68 + 16 * part + 4 * k), x1 = *(const LAS f32x4*)(OB + (size_t)(128 + q) * 68 + 16 * part + 4 * k);
            const f32x4 d = x0 - x1 * lam; o[4 * k] = d.x; o[4 * k + 1] = d.y; o[4 * k + 2] = d.z; o[4 * k + 3] = d.w; ss += (d.x * d.x + d.y * d.y) + (d.z * d.z + d.w * d.w); }
        ss += shfl_f(ss, lane ^ 1); ss += shfl_f(ss, lane ^ 2);
        const float rs = rsqrtf(ss * (1.f / 64.f) + EPS) * (1.f - lam_init);
        bf16* dst = c.MIX + ((size_t)b * S + qb * 128 + q) * 1024 + 512 + h * 64 + 16 * part;
#pragma unroll
        for (int k = 0; k < 2; ++k) *(v4u*)(dst + 8 * k) = (v4u){cvt2(o[8 * k] * rs * nw[8 * k], o[8 * k + 1] * rs * nw[8 * k + 1]), cvt2(o[8 * k + 2] * rs * nw[8 * k + 2], o[8 * k + 3] * rs * nw[8 * k + 3]),
                                                                 cvt2(o[8 * k + 4] * rs * nw[8 * k + 4], o[8 * k + 5] * rs * nw[8 * k + 5]), cvt2(o[8 * k + 6] * rs * nw[8 * k + 6], o[8 * k + 7] * rs * nw[8 * k + 7])};
    }
}

__device__ __forceinline__ void ml_out2_unit(const MixCtx& c, int up, LAS unsigned char* lds, int wave, int lane) {
    const int half = wave >> 2, li = wave & 3, u = 2 * up + half, h = u & 3, bc = u >> 2, t0 = bc * 128;
    const int ht = (wave & 3) * 64 + lane;
    const int r = lane & 31, hh = lane >> 5, l = 32 * li + r;
    LAS unsigned char* hb = lds + half * 73216;
    lf32 RM = (lf32)hb, U = (lf32)(hb + 512), MT = (lf32)(hb + 1024), WI = (lf32)(hb + 1536), NP = (lf32)(hb + 2048);
    lbf Q = (lbf)(hb + 2560), Kk = (lbf)(hb + 2560 + 18432), VS = (lbf)(hb + 2560 + 2 * 18432), CP = (lbf)(hb + 2560 + 2 * 18432 + 24576);
    lbf OT = Q;
    const unsigned char* ms = c.ws + WS_MISC;
    WG_BAR();
    v4u oraw[4];
#pragma unroll
    for (int k = 0; k < 4; ++k) { const int e = ht + 256 * k; oraw[k] = *(const v4u*)(c.PROJ + (size_t)(t0 + (e >> 3)) * PJ + O_MO + h * 64 + 8 * (e & 7)); }
    {
#pragma unroll
        for (int k = 0; k < 4; ++k) { const int e = ht + 256 * k, s = e >> 3, oct = e & 7; const bf16* row = c.PROJ + (size_t)(t0 + s) * PJ + h * 64 + 8 * oct;
            *(LAS v4u*)(Q + s * 72 + 8 * oct) = *(const v4u*)(row + O_MQ);
            float kv[8]; unpack8(*(const v4u*)(row + O_MK), kv);
#pragma unroll
            for (int q = 0; q < 8; ++q) kv[q] *= 0.125f;
            *(LAS v4u*)(Kk + s * 72 + 8 * oct) = pack8(kv);
            *(LAS v4u*)(VS + s * 96 + 8 * oct) = *(const v4u*)(row + O_MV); }
#pragma unroll
        for (int k = 0; k < 2; ++k) { const int e = ht + 256 * k; *(LAS v4u*)(CP + (e >> 3) * 72 + 8 * (e & 7)) = ((const v4u*)(c.cprev + (size_t)u * 4096))[e]; }
    }
    if (li == 0) {
        const float ib = c.in[I_MIB][c.L * 4 + h], fb = c.in[I_MFB][c.L * 4 + h];
        const float li0 = c.SMALL[(size_t)(t0 + 2 * lane) * 16 + SM_MI + h] + ib, li1 = c.SMALL[(size_t)(t0 + 2 * lane + 1) * 16 + SM_MI + h] + ib;
        float b0 = logsigmoid_fast(c.SMALL[(size_t)(t0 + 2 * lane) * 16 + SM_MF + h] + fb), b1 = logsigmoid_fast(c.SMALL[(size_t)(t0 + 2 * lane + 1) * 16 + SM_MF + h] + fb);
        scan_add128(b0, b1, lane);
        const float u0 = li0 - b0, u1 = li1 - b1; float p0 = u0, p1 = u1; scan_max128(p0, p1, lane);
        const float mp = ((const float*)(ms + MS_MP))[u];
        const float in0 = b0 + mp, in1 = b1 + mp, mt0 = fmaxf(in0, b0 + p0), mt1 = fmaxf(in1, b1 + p1);
        U[2 * lane] = u0; U[2 * lane + 1] = u1; RM[2 * lane] = b0 - mt0; RM[2 * lane + 1] = b1 - mt1; MT[2 * lane] = mt0; MT[2 * lane + 1] = mt1;
        WI[2 * lane] = __expf(in0 - mt0); WI[2 * lane + 1] = __expf(in1 - mt1);
        NP[lane] = ((const float*)(ms + MS_NL))[(size_t)u * 64 + lane];
    }
    WG_BAR();
    const float rml = RM[l], wil = WI[l];
    f32x16 a0 = zero16(), a1 = zero16();
    mma<false, false>(a0, CP, 72, 0, Q, 72, 32 * li, 64, lane);
    mma<false, false>(a1, CP, 72, 32, Q, 72, 32 * li, 64, lane);
#pragma unroll
    for (int i = 0; i < 16; ++i) { a0[i] *= wil; a1[i] *= wil; }
    float den = 0.f;
    {
#pragma unroll
        for (int k = 0; k < 4; ++k) { float qv[8]; unpack8(*(const LAS v4u*)(Q + l * 72 + 32 * hh + 8 * k), qv);
#pragma unroll
            for (int q = 0; q < 8; ++q) den += qv[q] * NP[32 * hh + 8 * k + q]; }
        den *= wil;
    }
#pragma unroll 1
    for (int si = 0; si <= li; ++si) {
        f32x16 st = zero16();
        mma<false, false>(st, Kk, 72, 32 * si, Q, 72, 32 * li, 64, lane);
        float us[16];
#pragma unroll
        for (int i = 0; i < 16; ++i) us[i] = U[32 * si + crow(i, hh)];
#pragma unroll
        for (int i = 0; i < 16; ++i) { const int s2 = 32 * si + crow(i, hh); const float w = st[i] * __expf(fminf(rml + us[i], 0.f)); st[i] = (si < li || s2 <= l) ? w : 0.f; den += st[i]; }
#pragma unroll
        for (int s2 = 0; s2 < 2; ++s2) {
            const v4u pw = {cvt2(st[8 * s2], st[8 * s2 + 1]), cvt2(st[8 * s2 + 2], st[8 * s2 + 3]), cvt2(st[8 * s2 + 4], st[8 * s2 + 5]), cvt2(st[8 * s2 + 6], st[8 * s2 + 7])};
            const bf16x8 pf = __builtin_bit_cast(bf16x8, pw);
            a0 = __builtin_amdgcn_mfma_f32_32x32x16_bf16(frag_tp(VS, 96, 32 * si + 16 * s2, 0, lane), pf, a0, 0, 0, 0);
            a1 = __builtin_amdgcn_mfma_f32_32x32x16_bf16(frag_tp(VS, 96, 32 * si + 16 * s2, 32, lane), pf, a1, 0, 0, 0);
        }
    }
    den = xhalf_sum(den);
    const float inv = 1.f / fmaxf(fabsf(den), __expf(-MT[l]));
    float ss = 0.f;
#pragma unroll
    for (int i = 0; i < 16; ++i) { a0[i] *= inv; a1[i] *= inv; ss += a0[i] * a0[i] + a1[i] * a1[i]; }
    ss = xhalf_sum(ss);
    const float rs = rsqrtf(ss * (1.f / 64.f) + EPS);
    WG_BAR();
    {
        const float* nw = c.in[I_MNW] + c.L * 256 + h * 64;
        lbf orow = OT + l * 72 + 4 * hh;
#pragma unroll
        for (int g = 0; g < 4; ++g) { const f32x4 w0 = *(const f32x4*)(nw + 8 * g + 4 * hh), w1 = *(const f32x4*)(nw + 32 + 8 * g + 4 * hh);
            *(LAS u32x2m*)(orow + 8 * g) = (u32x2m){cvt2(a0[4 * g] * rs * w0.x, a0[4 * g + 1] * rs * w0.y), cvt2(a0[4 * g + 2] * rs * w0.z, a0[4 * g + 3] * rs * w0.w)};
            *(LAS u32x2m*)(orow + 32 + 8 * g) = (u32x2m){cvt2(a1[4 * g] * rs * w1.x, a1[4 * g + 1] * rs * w1.y), cvt2(a1[4 * g + 2] * rs * w1.z, a1[4 * g + 3] * rs * w1.w)}; }
    }
    WG_BAR();
#pragma unroll
    for (int k = 0; k < 4; ++k) { const int e = ht + 256 * k, row = e >> 3, piece = e & 7;
        float hv[8], ov[8]; unpack8(*(const LAS v4u*)(OT + row * 72 + 8 * piece), hv); unpack8(oraw[k], ov);
#pragma unroll
        for (int q = 0; q < 8; ++q) hv[q] *= __builtin_amdgcn_rcpf(1.0f + __expf(-ov[q]));
        *(v4u*)(c.MIX + (size_t)(t0 + row) * 1024 + 768 + h * 64 + 8 * piece) = pack8(hv); }
}
}
constexpr int CW_BAR = 4096;
constexpr int N_BAR_REGIONS = 4;
static_assert((CW_BAR + N_BAR_REGIONS * XCD_BAR_WORDS) * 4 <= (int)CTL_ZERO_BYTES, "CTL words inside the memset region");
constexpr int RING_OFF = 0, RING_BYTES = 131072, PHASE_BYTES = 147456;
constexpr int LDSCTL_OFF = PHASE_BYTES, MISC_OFF = LDSCTL_OFF + 320;
constexpr int LDS_BYTES = PHASE_BYTES + 1024;
static_assert(MISC_OFF + 128 <= LDS_BYTES, "LDS map");
#define LDS_WAIT() asm volatile("s_waitcnt lgkmcnt(0)" ::: "memory")

struct Frame {
    LAS unsigned char* lds;
    volatile LAS unsigned* MISC;
    unsigned* ctl;
    int wave, G;
};
#define LANE() lane_id_asm()

__device__ __forceinline__ unsigned pk2(float lo, float hi) { return (unsigned)f2bf(lo) | ((unsigned)f2bf(hi) << 16); }
template <class RM>
__device__ __forceinline__ void transpose_item(const float* W, int K, int N, bf16* WT, RM rowmap, const float* kscale, LAS float* scr, int item, int lane) {
    const int nblk = (N + 31) / 32, kb = item / nblk, nb = item % nblk, k0 = 64 * kb, n0 = 32 * nb;
    const bool nok = (n0 + (lane & 31)) < N;
    float wv_[32];
    const int ncol = nok ? n0 + (lane & 31) : N - 1;
#pragma unroll
    for (int i = 0; i < 32; ++i) { const int kk = 2 * i + (lane >> 5); wv_[i] = W[(size_t)(k0 + kk) * N + ncol]; }
#pragma unroll
    for (int i = 0; i < 32; ++i) { const int kk = 2 * i + (lane >> 5); float v = wv_[i]; if (kscale) v *= kscale[k0 + kk]; scr[kk * 33 + (lane & 31)] = v; }
    LDS_WAIT(); asm volatile("" ::: "memory");
    const int c = lane & 7;
#pragma unroll
    for (int j = 0; j < 4; ++j) { const int n = (lane >> 3) + 8 * j; const LAS float* s = scr + (8 * c) * 33 + n;
        v4u o; o.x = pk2(s[0 * 33], s[1 * 33]); o.y = pk2(s[2 * 33], s[3 * 33]); o.z = pk2(s[4 * 33], s[5 * 33]); o.w = pk2(s[6 * 33], s[7 * 33]);
        if (n0 + n < N) *(v4u*)(WT + (size_t)rowmap(n0 + n) * K + k0 + 8 * c) = o; }
    LDS_WAIT(); asm volatile("" ::: "memory");
}
__device__ __forceinline__ int rowmap_win(int c) { return c < 1536 ? c : (c < 1544 ? 3328 + (c - 1536) : (c < 3336 ? c - 8 : 3328 + 8 + (c - 3336))); }

__device__ __forceinline__ void p0_prologue(Frame& F, const Args& a) {
    unsigned char* ws = a.ws;
    LAS float* scr = (LAS float*)(F.lds + RING_OFF + F.wave * 16384);
    const int lane = LANE(), tid = F.wave * 64 + lane;
    const int gw = blockIdx.x * NWAVES + F.wave, NGW = F.G * NWAVES;
    constexpr int I_IN = 16 * 105, I_SQ = 16 * 32, I_GU = 16 * 88, I_DN = 44 * 32, I_PPJ = 4 * 32;
    constexpr int PER_LAYER = I_IN + I_SQ + 2 * I_GU + I_DN + I_SQ + I_PPJ;
    for (int it = gw; it < DEPTH * PER_LAYER; it += NGW) {
        const int L = it / PER_LAYER; int r = it % PER_LAYER;
        unsigned char* wl = ws + WS_W + (size_t)L * W_LAYER;
        if (r < I_IN) { transpose_item(a.in[I_WIN] + (size_t)L * D * INC, D, INC, (bf16*)(wl + W_IN), [](int c) { return rowmap_win(c); }, a.in[I_N1W] + L * D, scr, r, lane); continue; } r -= I_IN;
        if (r < I_SQ) { transpose_item(a.in[I_WOUT] + (size_t)L * D * D, D, D, (bf16*)(wl + W_OUT), [](int c) { return c; }, nullptr, scr, r, lane); continue; } r -= I_SQ;
        if (r < I_GU) { transpose_item(a.in[I_WG] + (size_t)L * D * FF, D, FF, (bf16*)(wl + W_GU), [](int c) { return 256 * (c >> 7) + (c & 127); }, a.in[I_N2W] + L * D, scr, r, lane); continue; } r -= I_GU;
        if (r < I_GU) { transpose_item(a.in[I_WU] + (size_t)L * D * FF, D, FF, (bf16*)(wl + W_GU), [](int c) { return 256 * (c >> 7) + 128 + (c & 127); }, a.in[I_N2W] + L * D, scr, r, lane); continue; } r -= I_GU;
        if (r < I_DN) { transpose_item(a.in[I_WD] + (size_t)L * FF * D, FF, D, (bf16*)(wl + W_DN), [](int c) { return c; }, nullptr, scr, r, lane); continue; } r -= I_DN;
        if (r < I_SQ) { transpose_item(a.in[I_PGW] + (size_t)L * D * D, D, D, (bf16*)(wl + W_PG), [](int c) { return c; }, nullptr, scr, r, lane); continue; } r -= I_SQ;
        transpose_item(a.in[I_PPW] + (size_t)L * PLE * D, PLE, D, (bf16*)(wl + W_PP), [](int c) { return c; }, nullptr, scr, r, lane);
    }
    {
        const int gt = blockIdx.x * NT + tid, ngt = F.G * NT; constexpr int PER = (NPROJ - INC) * D / 8;
        for (int e = gt; e < DEPTH * PER; e += ngt) { const int L = e / PER, r = e % PER;
            *(v4u*)((bf16*)(ws + WS_W + (size_t)L * W_LAYER + W_IN) + (size_t)INC * D + (size_t)r * 8) = (v4u){0u, 0u, 0u, 0u}; }
    }
    {
        const float* x = a.in[I_X]; bf16* hb2 = (bf16*)(ws + WS_HB2); float* ssqp = (float*)(ws + WS_SSQP);
        for (int m = gw; m < M; m += 2 * NGW) {
            const int m2 = (m + NGW < M) ? m + NGW : m;
            const f32x4* xa = (const f32x4*)(x + (size_t)m * D) + lane; const f32x4* xb = (const f32x4*)(x + (size_t)m2 * D) + lane;
            f32x4 va[4], vb[4];
#pragma unroll
            for (int j = 0; j < 4; ++j) { va[j] = xa[64 * j]; vb[j] = xb[64 * j]; }
            unsigned long long* oa = (unsigned long long*)(hb2 + (size_t)m * D) + lane; unsigned long long* ob = (unsigned long long*)(hb2 + (size_t)m2 * D) + lane; float sa = 0.f, sb = 0.f;
#pragma unroll
            for (int j = 0; j < 4; ++j) { sa += (va[j].x * va[j].x + va[j].y * va[j].y) + (va[j].z * va[j].z + va[j].w * va[j].w); sb += (vb[j].x * vb[j].x + vb[j].y * vb[j].y) + (vb[j].z * vb[j].z + vb[j].w * vb[j].w);
                oa[64 * j] = (unsigned long long)pk2(va[j].x, va[j].y) | ((unsigned long long)pk2(va[j].z, va[j].w) << 32); ob[64 * j] = (unsigned long long)pk2(vb[j].x, vb[j].y) | ((unsigned long long)pk2(vb[j].z, vb[j].w) << 32); }
            sa = wave_sum_l(sa, lane); sb = wave_sum_l(sb, lane);
            if (lane < 16) { ssqp[(size_t)m * 16 + lane] = (lane == 0) ? sa : 0.f; ssqp[(size_t)m2 * 16 + lane] = (lane == 0) ? sb : 0.f; }
        }
    }
    {
        const float* p = a.in[I_P]; bf16* pb = (bf16*)(ws + WS_PB);
        const size_t gt = (size_t)blockIdx.x * NT + tid, ngt = (size_t)F.G * NT, n8 = (size_t)DEPTH * M * PLE / 8;
        for (size_t e = gt; e < n8; e += 4 * ngt) {
            f32x4 v0[4], v1[4];
#pragma unroll
            for (int k = 0; k < 4; ++k) { const size_t ek = (e + k * ngt < n8) ? e + k * ngt : e; v0[k] = *(const f32x4*)(p + ek * 8); v1[k] = *(const f32x4*)(p + ek * 8 + 4); }
#pragma unroll
            for (int k = 0; k < 4; ++k) if (e + k * ngt < n8) *(v4u*)(pb + (e + k * ngt) * 8) = (v4u){pk2(v0[k].x, v0[k].y), pk2(v0[k].z, v0[k].w), pk2(v1[k].x, v1[k].y), pk2(v1[k].z, v1[k].w)};
        }
    }
}

constexpr int NTN = 256;
template <int PH> __global__ void __launch_bounds__(NTN, 1) naive_mix(Args a, int L) {
    extern __shared__ __attribute__((aligned(16))) unsigned char lds_raw[];
    float* ldsf = (float*)lds_raw;
    const int tid = threadIdx.x, lane = tid & 63, wave = tid >> 6;
    const int gtid = blockIdx.x * NTN + tid, gthreads = gridDim.x * NTN;
    const int gw = blockIdx.x * (NTN / 64) + wave, ngw = gridDim.x * (NTN / 64);
    unsigned char* ws = a.ws;
    const bf16* PROJ = (const bf16*)(ws + WS_PROJ); const float* SMALL = (const float*)(ws + WS_SMALL);
    bf16* XC = (bf16*)(ws + WS_XC); bf16* MIX = (bf16*)(ws + WS_MIX);
    if constexpr (PH == 2) {
        const float* cw = a.in[I_CONVW] + L * 4 * 1024; const float* cb = a.in[I_CONVB] + L * 1024;
        for (size_t e = gtid; e < (size_t)M * 1024; e += gthreads) {
            const int ch = (int)(e & 1023), t = (int)(e >> 10), s = t & (S - 1);
            float acc = cb[ch];
#pragma unroll
            for (int k = 0; k < 4; ++k) { const int ss = s - 3 + k; if (ss >= 0) acc += cw[k * 1024 + ch] * bf2f(PROJ[(size_t)(t - 3 + k) * PJ + O_XBC + ch]); }
            XC[e] = f2bf(siluf_(acc));
        }
    }
    if constexpr (PH == 3) {
        for (int u = gw; u < NB * 8; u += ngw) {
            const int b = u >> 3, hd = u & 7, g = hd >> 2;
            const float dtb = a.in[I_DTB][L * 8 + hd], A = -expf(a.in[I_ALOG][L * 8 + hd]), Dsk = a.in[I_SSDD][L * 8 + hd];
            float st[128];
#pragma unroll
            for (int n = 0; n < 128; ++n) st[n] = 0.f;
            for (int s = 0; s < S; ++s) {
                const size_t t = (size_t)b * S + s;
                const float dt = softplusf_(SMALL[t * 16 + SM_DT + hd] + dtb), dA = expf(dt * A);
                const float x = bf2f(XC[t * 1024 + hd * 64 + lane]), xdt = x * dt;
                const v4u* Bp = (const v4u*)(XC + t * 1024 + 512 + g * 128); const v4u* Cp = (const v4u*)(XC + t * 1024 + 768 + g * 128);
                float y = 0.f;
#pragma unroll
                for (int n8 = 0; n8 < 16; ++n8) { const v4u bw = Bp[n8], cw = Cp[n8];
#pragma unroll
                    for (int j = 0; j < 4; ++j) { const unsigned bu = bw[j], cu = cw[j]; const int n = 8 * n8 + 2 * j;
                        st[n] = st[n] * dA + __uint_as_float(bu << 16) * xdt; y += __uint_as_float(cu << 16) * st[n];
                        st[n + 1] = st[n + 1] * dA + __uint_as_float(bu & 0xffff0000u) * xdt; y += __uint_as_float(cu & 0xffff0000u) * st[n + 1]; } }
                MIX[t * 1024 + hd * 64 + lane] = f2bf(y + x * Dsk);
            }
        }
    }
    if constexpr (PH == 4) {
        const float* nw = a.in[I_SSDNW] + L * 512;
        for (int m = gw; m < M; m += ngw) {
            float gv[8]; float s = 0.f;
#pragma unroll
            for (int j = 0; j < 8; ++j) { const int c = lane * 8 + j; const float z = bf2f(PROJ[(size_t)m * PJ + O_Z + c]); gv[j] = bf2f(MIX[(size_t)m * 1024 + c]) * siluf_(z); s += gv[j] * gv[j]; }
            const float r = rsqrtf(wave_sum(s) * (1.f / 512.f) + EPS);
#pragma unroll
            for (int j = 0; j < 8; ++j) { const int c = lane * 8 + j; MIX[(size_t)m * 1024 + c] = f2bf(gv[j] * r * nw[c]); }
        }
    }
    if constexpr (PH == 5) {
        float* lut = ldsf;
        const float lam_init = 0.8f - 0.6f * expf(-0.3f * (float)L);
        float d1 = 0.f, d2 = 0.f;
        for (int i = 0; i < 32; ++i) { d1 += a.in[I_LQ1][L * 32 + i] * a.in[I_LK1][L * 32 + i]; d2 += a.in[I_LQ2][L * 32 + i] * a.in[I_LK2][L * 32 + i]; }
        const float lam = expf(d1) - expf(d2) + lam_init;
        const float* dnw = a.in[I_DNW] + L * 64;
        for (int vb = blockIdx.x; vb < M * 4 / NTN; vb += gridDim.x) {
            const int gid = vb * NTN + tid, q = gid & (S - 1), h = (gid >> 11) & 3, b = gid >> 13;
            __syncthreads();
            if (tid < 128) lut[tid] = a.in[I_RELB][T5_BUCKET[tid] * 4 + h];
            __syncthreads();
            const size_t t = (size_t)b * S + q;
            float q0[32], q1[32];
            const float sc = 0.17677669529663687f;
#pragma unroll
            for (int d = 0; d < 32; ++d) { q0[d] = bf2f(PROJ[t * PJ + O_DQ + h * 64 + d]) * sc; q1[d] = bf2f(PROJ[t * PJ + O_DQ + h * 64 + 32 + d]) * sc; }
            float m0 = -1e30f, l0 = 0.f, m1 = -1e30f, l1 = 0.f;
            const int kend = q | 63;
            for (int k = 0; k <= kend; ++k) {
                const bf16* kp = PROJ + ((size_t)b * S + k) * PJ + O_DK + h * 64;
                float s0 = 0.f, s1 = 0.f;
#pragma unroll
                for (int d = 0; d < 32; ++d) { s0 += q0[d] * bf2f(kp[d]); s1 += q1[d] * bf2f(kp[32 + d]); }
                if (k <= q) {
                    const int dist = q - k; const float bias = lut[dist < 127 ? dist : 127];
                    s0 += bias; s1 += bias;
                    if (s0 > m0) { l0 = l0 * __expf(m0 - s0) + 1.f; m0 = s0; } else l0 += __expf(s0 - m0);
                    if (s1 > m1) { l1 = l1 * __expf(m1 - s1) + 1.f; m1 = s1; } else l1 += __expf(s1 - m1);
                }
            }
            float o[64];
#pragma unroll
            for (int e = 0; e < 64; ++e) o[e] = 0.f;
            const float il0 = 1.f / l0, il1 = lam / l1;
            for (int k = 0; k <= kend; ++k) {
                const bf16* kp = PROJ + ((size_t)b * S + k) * PJ + O_DK + h * 64;
                const bf16* vp = PROJ + ((size_t)b * S + k) * PJ + O_DV + h * 64;
                float s0 = 0.f, s1 = 0.f;
#pragma unroll
                for (int d = 0; d < 32; ++d) { s0 += q0[d] * bf2f(kp[d]); s1 += q1[d] * bf2f(kp[32 + d]); }
                float w = 0.f;
                if (k <= q) { const int dist = q - k; const float bias = lut[dist < 127 ? dist : 127]; w = __expf(s0 + bias - m0) * il0 - __expf(s1 + bias - m1) * il1; }
#pragma unroll
                for (int e = 0; e < 64; ++e) o[e] += w * bf2f(vp[e]);
            }
            float ss = 0.f;
#pragma unroll
            for (int e = 0; e < 64; ++e) ss += o[e] * o[e];
            const float r = rsqrtf(ss * (1.f / 64.f) + EPS) * (1.f - lam_init);
#pragma unroll
            for (int e = 0; e < 64; ++e) MIX[t * 1024 + 512 + h * 64 + e] = f2bf(o[e] * r * dnw[e]);
        }
    }
    if constexpr (PH == 6) {
        for (int u = gw; u < NB * 4; u += ngw) {
            const int b = u >> 2, h = u & 3;
            const float ib = a.in[I_MIB][L * 4 + h], fb = a.in[I_MFB][L * 4 + h], nwe = a.in[I_MNW][L * 256 + h * 64 + lane];
            float C[64], nv[64];
#pragma unroll
            for (int d = 0; d < 64; ++d) { C[d] = 0.f; nv[d] = 0.f; }
            float mprev = 0.f;
            for (int s = 0; s < S; ++s) {
                const size_t t = (size_t)b * S + s; const bf16* row = PROJ + t * PJ;
                const float logi = SMALL[t * 16 + SM_MI + h] + ib, logf_ = logsigmoidf_(SMALL[t * 16 + SM_MF + h] + fb);
                const float mnew = fmaxf(logf_ + mprev, logi), fa = expf(logf_ + mprev - mnew), ia = expf(logi - mnew);
                const float ve = bf2f(row[O_MV + h * 64 + lane]) * ia;
                float num = 0.f, den = 0.f;
#pragma unroll
                for (int d = 0; d < 64; ++d) {
                    const float kd = bf2f(row[O_MK + h * 64 + d]) * 0.125f, qd = bf2f(row[O_MQ + h * 64 + d]);
                    C[d] = C[d] * fa + ve * kd; nv[d] = nv[d] * fa + ia * kd; num += C[d] * qd; den += nv[d] * qd;
                }
                const float hv = num / fmaxf(fabsf(den), expf(-mnew));
                const float r = rsqrtf(wave_sum(hv * hv) * (1.f / 64.f) + EPS);
                MIX[t * 1024 + 768 + h * 64 + lane] = f2bf(sigmoidf_(bf2f(row[O_MO + h * 64 + lane])) * hv * r * nwe);
                mprev = mnew;
            }
        }
    }
}

__device__ __forceinline__ void fill_rstd_table(const pg8::StaticOrder& So, const float* ssqp, LAS float* rtab, int wave, int lane) {
    const int tid = wave * 64 + lane;
    for (int i = tid >> 8; ; i += 2) { pg8::Unit u; if (!So.next(i, u)) break;
        const f32x4* p = (const f32x4*)(ssqp + (size_t)(u.pm * 256 + (tid & 255)) * 16);
        const f32x4 a = p[0], b = p[1], c = p[2], d = p[3];
        const float s = (((a.x + a.y) + (a.z + a.w)) + ((b.x + b.y) + (b.z + b.w))) + (((c.x + c.y) + (c.z + c.w)) + ((d.x + d.y) + (d.z + d.w)));
        rtab[i * 256 + (tid & 255)] = rsqrtf(s * (1.0f / 1024.0f) + EPS); }
    __syncthreads();
}

#ifndef SMALL_WGM
#define SMALL_WGM 4
#endif
constexpr int PH_FINAL = 1 + 8 * DEPTH, PH_END = PH_FINAL + 1;
__global__ void __launch_bounds__(NT, 2) mk_fwd(Args a) {
    extern __shared__ __attribute__((aligned(16))) unsigned char lds[];
    Frame F;
    F.lds = (LAS unsigned char*)lds;
    F.MISC = (volatile LAS unsigned*)(F.lds + MISC_OFF);
    F.wave = __builtin_amdgcn_readfirstlane(threadIdx.x >> 6);
    F.G = gridDim.x;
    unsigned char* ws = a.ws;
    F.ctl = (unsigned*)(ws + WS_CTL);
    for (int u = F.wave * 64 + LANE(); u < (LDS_BYTES - LDSCTL_OFF) / 4; u += NT) ((LAS unsigned*)(F.lds + LDSCTL_OFF))[u] = 0u;
    __syncthreads();
    XcdBarrier bar = xcd_barrier_post(F.ctl + CW_BAR + a.li * XCD_BAR_WORDS, F.MISC + 8, F.wave);
    const int lo = a.ph_lo, hi = a.ph_hi;
#define IN(k) (lo <= (k) && (k) < hi)
#define SEAM(k) do { if (IN(k) && IN((k) + 1)) xcd_barrier(bar); } while (0)
#ifndef DUP_MASK
#define DUP_MASK 0
#endif
#define DUP(kk) (((DUP_MASK) >> (kk)) & 1)
#ifndef DUP_PARTS
#define DUP_PARTS 7
#endif
    float* H = a.out;
    float* SSQP = (float*)(ws + WS_SSQP); float* SMALL = (float*)(ws + WS_SMALL);
    pg8::bf16_t* HB = (pg8::bf16_t*)(ws + WS_HB); pg8::bf16_t* HB2 = (pg8::bf16_t*)(ws + WS_HB2);
    pg8::bf16_t* PROJ = (pg8::bf16_t*)(ws + WS_PROJ); pg8::bf16_t* HID = (pg8::bf16_t*)(ws + WS_HID);
    pg8::bf16_t* MIX = (pg8::bf16_t*)(ws + WS_MIX); pg8::bf16_t* PP = (pg8::bf16_t*)(ws + WS_PP);

    if (IN(0)) { p0_prologue(F, a); }
#if DUP(8)
    if (IN(0)) { xcd_barrier(bar); p0_prologue(F, a); }
#endif
    SEAM(0);

    for (int L = 0; L < DEPTH; ++L) {
        const int P0 = 1 + 8 * L;
        const unsigned char* wl = ws + WS_W + (size_t)L * W_LAYER;
#define BODY_G1 \
            pg8::Gemm g{HB2, (const pg8::bf16_t*)(wl + W_IN), M, NPROJ, D}; pg8::StaticOrder So; So.init(M, NPROJ, F.G, (int)blockIdx.x); \
            fill_rstd_table(So, SSQP, (LAS float*)(F.lds + RING_BYTES), F.wave, LANE()); \
            pg8::EpiProj E{PROJ, SMALL, (const LAS float*)(F.lds + RING_BYTES)}; \
            pg8::gemm_phase<pg8::EpiProj, pg8::StaticOrder, true, true>(F.wave, F.lds + RING_OFF, g, So, E); \

        if (IN(P0 + 0)) { BODY_G1 }
#if DUP(0)
        if (IN(P0 + 0)) { xcd_barrier(bar); BODY_G1 }
#endif
        SEAM(P0 + 0);
        const mx::MixCtx mc{(const bf16*)PROJ, SMALL, (bf16*)MIX, ws, a.in, L, H, H + (size_t)16 * 1024 * 1024, (bf16*)(H + (size_t)20 * 1024 * 1024), (bf16*)(H + (size_t)28 * 1024 * 1024)};
#define BODY_A \
            const float lam_init = __int_as_float(__builtin_amdgcn_readfirstlane(__float_as_int(0.8f - 0.6f * __expf(-0.3f * (float)L)))); \
            float d1 = 0.f, d2 = 0.f; \
            for (int i = 0; i < 32; ++i) { d1 += a.in[I_LQ1][L * 32 + i] * a.in[I_LK1][L * 32 + i]; d2 += a.in[I_LQ2][L * 32 + i] * a.in[I_LK2][L * 32 + i]; } \
            const float lam_v = __expf(d1) - __expf(d2) + lam_init; \
            const float lam = __int_as_float(__builtin_amdgcn_readfirstlane(__float_as_int(lam_v))); \
            for (int u = blockIdx.x; u < 2048; u += F.G) { \
                const int lane = LANE(); \
                if (u < 512) { if (PARTS & 1) {   \
                    const int x_ = u & 7, t_ = (u >> 3) & 63, bh = (F.G == 256) ? x_ + 8 * (t_ >> 3) : u >> 3, j = (F.G == 256) ? (t_ & 7) : (u & 7); \
                    mx::attn3_unit(mc, bh >> 2, bh & 3, 15 - j, lam, lam_init, F.lds, F.wave, lane); mx::attn3_unit(mc, bh >> 2, bh & 3, j, lam, lam_init, F.lds, F.wave, lane); } } \
                else if (u < 1024) { if (PARTS & 2) mx::ssd_states_unit(mc, u - 512, F.lds, F.wave, lane); } \
                else { if (PARTS & 4) mx::ml_summary_unit(mc, u - 1024, F.lds, F.wave, lane); } \
            } \

#define PARTS 7
        if (IN(P0 + 1)) { BODY_A }
#undef PARTS
#define PARTS DUP_PARTS
#if DUP(1)
        if (IN(P0 + 1)) { xcd_barrier(bar); BODY_A }
#endif
#undef PARTS
        SEAM(P0 + 1);
        if (IN(P0 + 2)) mx::scan_phase(mc, F.G, F.wave, LANE());
#if DUP(2)
#define PARTS 6
        if (IN(P0 + 2)) { xcd_barrier(bar); { BODY_A } xcd_barrier(bar); mx::scan_phase(mc, F.G, F.wave, LANE()); }
#undef PARTS
#endif
        SEAM(P0 + 2);
#define BODY_C \
            for (int u = blockIdx.x; u < 768; u += F.G) { \
                const int lane = LANE(); \
                if (u < 256) { if (PARTS & 1) mx::ssd_out_unit(mc, u, F.lds, F.wave, lane); } \
                else { if (PARTS & 2) mx::ml_out2_unit(mc, u - 256, F.lds, F.wave, lane); } \
            } \

#ifdef SSD_PROBE_VAR
        if (IN(P0 + 3)) { for (int u = blockIdx.x; u < 256; u += F.G) mx::ssd_out_unit<SSD_PROBE_VAR>(mc, u, F.lds, F.wave, LANE()); xcd_barrier(bar); }
#endif
#define PARTS 7
        if (IN(P0 + 3)) { BODY_C }
#undef PARTS
#define PARTS DUP_PARTS
#if DUP(3)
        if (IN(P0 + 3)) { xcd_barrier(bar); BODY_C }
#endif
#undef PARTS
        SEAM(P0 + 3);
        if (IN(P0 + 4)) {
            pg8::Gemm g{MIX, (const pg8::bf16_t*)(wl + W_OUT), M, D, D}; pg8::StaticOrder So; So.init(M, D, F.G, (int)blockIdx.x, SMALL_WGM);
            if (L == 0) { pg8::EpiRes<0, true> E{a.in[I_X], HB, SSQP, nullptr};
                pg8::gemm_phase<pg8::EpiRes<0, true>, pg8::StaticOrder, true, true>(F.wave, F.lds + RING_OFF, g, So, E); }
            else { pg8::EpiRes<0, false> E{HB2, HB, SSQP, nullptr};
                pg8::gemm_phase<pg8::EpiRes<0, false>, pg8::StaticOrder, true, true>(F.wave, F.lds + RING_OFF, g, So, E); }
        }
        SEAM(P0 + 4);
#define BODY_G3 \
            pg8::Gemm g{HB, (const pg8::bf16_t*)(wl + W_GU), M, 2 * FF, D}; pg8::StaticOrder So; So.init(M, 2 * FF, F.G, (int)blockIdx.x); \
            fill_rstd_table(So, SSQP, (LAS float*)(F.lds + RING_BYTES), F.wave, LANE()); \
            pg8::EpiGateUp E{HID, (const LAS float*)(F.lds + RING_BYTES)}; \
            pg8::gemm_phase<pg8::EpiGateUp, pg8::StaticOrder, true, true>(F.wave, F.lds + RING_OFF, g, So, E); \

        if (IN(P0 + 5)) { BODY_G3 }
#if DUP(5)
        if (IN(P0 + 5)) { xcd_barrier(bar); BODY_G3 }
#endif
        SEAM(P0 + 5);
        if (IN(P0 + 6)) {
            { pg8::Gemm g{HID, (const pg8::bf16_t*)(wl + W_DN), M, D, FF}; pg8::StaticOrder So; So.init(M, D, F.G, (int)blockIdx.x, SMALL_WGM);
              pg8::EpiRes<1, false> E{HB, HB, nullptr, nullptr};
              pg8::gemm_phase<pg8::EpiRes<1, false>, pg8::StaticOrder, true, true>(F.wave, F.lds + RING_OFF, g, So, E); }
            { pg8::Gemm g{(const pg8::bf16_t*)(ws + WS_PB) + (size_t)L * M * PLE, (const pg8::bf16_t*)(wl + W_PP), M, D, PLE}; pg8::StaticOrder So; So.init(M, D, F.G, (int)blockIdx.x, SMALL_WGM);
              pg8::EpiBf16<0> E{PP, D, nullptr, 0, 0, 1.f};
              pg8::gemm_phase<pg8::EpiBf16<0>, pg8::StaticOrder, true, true>(F.wave, F.lds + RING_OFF, g, So, E); }
        }
        SEAM(P0 + 6);
        if (IN(P0 + 7)) {
            pg8::Gemm g{HB, (const pg8::bf16_t*)(wl + W_PG), M, D, D}; pg8::StaticOrder So; So.init(M, D, F.G, (int)blockIdx.x, SMALL_WGM);
            pg8::EpiRes<2, false> E{HB, HB2, SSQP, PP};
            pg8::gemm_phase<pg8::EpiRes<2, false>, pg8::StaticOrder, true, true>(F.wave, F.lds + RING_OFF, g, So, E);
        }
        SEAM(P0 + 7);
    }
    if (IN(PH_FINAL)) {
        const float* fw = a.in[I_FNW]; const int gw = blockIdx.x * NWAVES + F.wave, NGW = F.G * NWAVES, lane = LANE();
        f32x4 wv[4];
#pragma unroll
        for (int j = 0; j < 4; ++j) wv[j] = ((const f32x4*)fw)[2 * lane + 128 * (j >> 1) + (j & 1)];
        for (int m0 = gw; m0 < M; m0 += 2 * NGW) {
            v4u w0[2], w1[2]; float sp_[2];
#pragma unroll
            for (int k = 0; k < 2; ++k) { const int m = (m0 + k * NGW < M) ? m0 + k * NGW : m0; const v4u* src = (const v4u*)(HB2 + (size_t)m * D) + lane; w0[k] = src[0]; w1[k] = src[64]; sp_[k] = (lane < 16) ? SSQP[(size_t)m * 16 + lane] : 0.f; }
#pragma unroll
            for (int k = 0; k < 2; ++k) { const int m = (m0 + k * NGW < M) ? m0 + k * NGW : m0; f32x4* dst = (f32x4*)(H + (size_t)m * D) + 2 * lane; float s = sp_[k];
                s += shfl_f(s, lane ^ 1); s += shfl_f(s, lane ^ 2); s += shfl_f(s, lane ^ 4); s += shfl_f(s, lane ^ 8);
                const float rs = rsqrtf(shfl_f(s, 0) * (1.f / D) + EPS);
                float v0[8], v1[8]; mx::unpack8(w0[k], v0); mx::unpack8(w1[k], v1);
                dst[0] = (f32x4){v0[0], v0[1], v0[2], v0[3]} * rs * wv[0]; dst[1] = (f32x4){v0[4], v0[5], v0[6], v0[7]} * rs * wv[1];
                dst[128] = (f32x4){v1[0], v1[1], v1[2], v1[3]} * rs * wv[2]; dst[129] = (f32x4){v1[4], v1[5], v1[6], v1[7]} * rs * wv[3]; }
        }
    }
#undef IN
#undef SEAM
}

extern "C" void kernel_launch(void* const* d_in, const int* in_sizes, int n_in, void* d_out, int out_size, void* d_ws, size_t ws_size, hipStream_t stream) {
    static int grid = 0;
    if (grid == 0) {
        if (n_in != 27 || in_sizes[0] != M * D || out_size != M * D || ws_size < WS_END) { fprintf(stderr, "kernel_launch: unexpected shapes (n_in %d, ws %zu)\n", n_in, ws_size); grid = -1; return; }
        int dev = 0, cus = 0, per_cu = 0;
        if (hipGetDevice(&dev) != hipSuccess || hipDeviceGetAttribute(&cus, hipDeviceAttributeMultiprocessorCount, dev) != hipSuccess) { grid = -1; return; }
        if (hipFuncSetAttribute((const void*)mk_fwd, hipFuncAttributeMaxDynamicSharedMemorySize, LDS_BYTES) != hipSuccess) { fprintf(stderr, "kernel_launch: hipFuncSetAttribute failed\n"); grid = -1; return; }
        if (hipOccupancyMaxActiveBlocksPerMultiprocessor(&per_cu, (const void*)mk_fwd, NT, LDS_BYTES) != hipSuccess || per_cu < 1) fprintf(stderr, "kernel_launch: occupancy query reports %d\n", per_cu);
        (void)hipGetLastError();
        grid = cus;
    }
    if (grid < 0) return;
    if (hipMemsetAsync((char*)d_ws + WS_CTL, 0, CTL_ZERO_BYTES, stream) != hipSuccess) return;
    Args a{};
    for (int i = 0; i < 27; ++i) a.in[i] = (const float*)d_in[i];
    a.out = (float*)d_out; a.ws = (unsigned char*)d_ws;
#define MK(lo_, hi_, li_) do { a.ph_lo = (lo_); a.ph_hi = (hi_); a.li = (li_); hipLaunchKernelGGL(mk_fwd, dim3(grid), dim3(NT), LDS_BYTES, stream, a); } while (0)
#define NAIVE(PH, L) hipLaunchKernelGGL(naive_mix<PH>, dim3(2048), dim3(NTN), 1024, stream, a, L)
    MK(0, PH_END, 0);
}
```

```cpp
#include <hip/hip_runtime.h>
#include <cstdint>
#include <cstdio>

typedef unsigned short bf16;
constexpr int NB = 16, S = 2048, D = 1024, M = NB * S, DEPTH = 2;
constexpr int INC = 3344, FF = 2816, PLE = 256;
constexpr float EPS = 1e-6f;
constexpr int NWAVES = 8, NT = NWAVES * 64;
constexpr int PJ = 3328, NPROJ = 3584;
constexpr int O_Z = 0, O_XBC = 512, O_DQ = 1536, O_DK = 1792, O_DV = 2048, O_MQ = 2304, O_MK = 2560, O_MV = 2816, O_MO = 3072;
constexpr int SM_DT = 0, SM_MI = 8, SM_MF = 12;

constexpr size_t MiB = 1u << 20;
constexpr size_t WS_CTL = 0, CTL_ZERO_BYTES = 1 * MiB;
constexpr size_t WS_W = 1 * MiB;
constexpr size_t W_IN = 0, W_OUT = 7 * MiB, W_GU = 9 * MiB, W_DN = 20 * MiB, W_PG = 25 * MiB + 512 * 1024, W_PP = 27 * MiB + 512 * 1024, W_LAYER = 28 * MiB;
constexpr size_t WS_SSQP = 57 * MiB;
constexpr size_t WS_SMALL = 59 * MiB;
constexpr size_t WS_MISC = 61 * MiB;
constexpr size_t WS_HB = 64 * MiB;
constexpr size_t WS_PROJ = 128 * MiB;
constexpr size_t WS_HID = WS_PROJ;
constexpr size_t WS_MIX = 336 * MiB;
constexpr size_t WS_PP = WS_MIX;
constexpr size_t WS_PB = 400 * MiB;
constexpr size_t WS_HB2 = 432 * MiB;
constexpr size_t WS_XC = 432 * MiB;
constexpr size_t WS_END = 496 * MiB;

__device__ __forceinline__ float bf2f(bf16 v) { return __uint_as_float((unsigned)v << 16); }
__device__ __forceinline__ bf16 f2bf(float f) { unsigned u = __float_as_uint(f); return (bf16)((u + 0x7fffu + ((u >> 16) & 1u)) >> 16); }
__device__ __forceinline__ float sigmoidf_(float x) { return 1.f / (1.f + __expf(-x)); }
__device__ __forceinline__ float siluf_(float x) { return x * sigmoidf_(x); }
__device__ __forceinline__ float softplusf_(float x) { return x > 20.f ? x : log1pf(expf(x)); }
__device__ __forceinline__ float logsigmoidf_(float x) { return fminf(x, 0.f) - log1pf(expf(-fabsf(x))); }
__device__ __forceinline__ float log1pexp_fast(float x) { const float y = __expf(x); const float r = (y < 0.03125f) ? y * (1.f - y * (0.5f - y * 0.33333334f)) : __logf(1.f + y); return x > 15.f ? x : r; }
__device__ __forceinline__ float softplus_fast(float x) { return log1pexp_fast(x); }
__device__ __forceinline__ float logsigmoid_fast(float x) { return fminf(x, 0.f) - log1pexp_fast(-fabsf(x)); }
__device__ __forceinline__ int lane_id_asm() { int l; asm volatile("v_mbcnt_lo_u32_b32 %0, -1, 0\n\tv_mbcnt_hi_u32_b32 %0, -1, %0" : "=v"(l)); return l; }
__device__ __forceinline__ float shfl_f(float v, int src) { return __int_as_float(__builtin_amdgcn_ds_bpermute(src << 2, __float_as_int(v))); }
__device__ __forceinline__ float wave_sum(float v) {
#pragma unroll
    for (int o = 1; o < 64; o <<= 1) v += __shfl_xor(v, o);
    return v;
}
__device__ __forceinline__ float wave_sum_l(float v, int lane) {
#pragma unroll
    for (int o = 1; o < 64; o <<= 1) v += shfl_f(v, lane ^ o);
    return v;
}
__constant__ unsigned char T5_BUCKET[128] = {0,1,2,3,4,5,6,7,8,9,10,11,12,13,14,15,16,16,16,17,17,18,18,18,19,19,19,20,20,20,20,21,21,21,21,22,22,22,22,22,23,23,23,23,23,23,24,24,24,24,24,24,25,25,25,25,25,25,25,26,26,26,26,26,26,26,26,27,27,27,27,27,27,27,27,27,27,28,28,28,28,28,28,28,28,28,28,29,29,29,29,29,29,29,29,29,29,29,29,30,30,30,30,30,30,30,30,30,30,30,30,30,30,31,31,31,31,31,31,31,31,31,31,31,31,31,31,31};
enum { I_X = 0, I_P, I_N1W, I_WIN, I_CONVW, I_CONVB, I_DTB, I_ALOG, I_SSDD, I_SSDNW, I_LQ1, I_LK1, I_LQ2, I_LK2, I_DNW, I_RELB, I_MIB, I_MFB, I_MNW, I_WOUT, I_N2W, I_WG, I_WU, I_WD, I_PGW, I_PPW, I_FNW };
struct Args { const float* in[27]; float* out; unsigned char* ws; int ph_lo, ph_hi, li, pad; };
namespace pg8 {
#define PG8_LAS __attribute__((address_space(3)))
typedef unsigned short bf16_t;
typedef short bf16x8 __attribute__((ext_vector_type(8)));
typedef float f32x4 __attribute__((ext_vector_type(4)));
typedef unsigned u32x4 __attribute__((ext_vector_type(4)));
constexpr int BM = 256, BK = 64, HALF = 128, HTB = HALF * BK * 2  , STAGE_BYTES = 8 * HTB, NXCD = 8;

__host__ __device__ __forceinline__ int lds_byte(int r, int c) { const int st = (r >> 4) * 2 + (c >> 5), rr = r & 15, cc = c & 31, ob = rr * 64 + cc * 2; return st * 1024 + (ob ^ (((ob >> 9) & 1) << 5)); }
__host__ __device__ __forceinline__ void stage_rc(int b, int& R, int& C) { const int st = b / 1024, sb = b % 1024, swz = sb ^ (((sb >> 9) & 1) << 5); R = (st >> 1) * 16 + swz / 64; C = (st & 1) * 32 + (swz % 64) / 2; }
__host__ __device__ __forceinline__ int perm32(int rho) { const int n = rho >> 4, i = rho & 15; return 8 * (i >> 2) + 4 * n + (i & 3); }

struct Unit { int pm, pn, ord; };
struct Gemm { const bf16_t* A; const bf16_t* Bt; int M, N, K; };

struct StaticOrder {
    int nM, nN, nwg, G, c, WGM;
    __host__ __device__ void init(int M, int N, int G_, int c_, int wgm_ = 4) { nM = M / BM; nN = N / BM; nwg = nM * nN; G = G_; c = c_; WGM = wgm_; }
    __host__ __device__ bool next(int i, Unit& u) const {
        const long L = (long)i * G + c; if (L >= nwg) return false;
        int wgid = (int)L; { const int q = nwg / NXCD, r = nwg % NXCD, xcd = wgid % NXCD, off = wgid / NXCD; wgid = (xcd < r ? xcd * (q + 1) : r * (q + 1) + (xcd - r) * q) + off; }
        const int nig = WGM * nN, gid = wgid / nig, fm = gid * WGM, gsz = (nM - fm) < WGM ? (nM - fm) : WGM;
        u.pm = fm + ((wgid % nig) % gsz); u.pn = (wgid % nig) / gsz; return true;
    }
    __device__ __forceinline__ void a_ready(const Unit&) const {}
    __device__ __forceinline__ void done(const Unit&) const {}
};

__device__ __forceinline__ unsigned cvt_pk_bf16(float lo, float hi) { unsigned r; asm volatile("v_cvt_pk_bf16_f32 %0, %1, %2" : "=v"(r) : "v"(lo), "v"(hi)); return r; }
typedef float f32x2 __attribute__((ext_vector_type(2)));
__device__ __forceinline__ f32x2 gelu_pk(f32x2 v) {
    const f32x2 av = __builtin_elementwise_abs(v), d = av * 0.2316418882f + 1.0f;
    f32x2 t; t.x = __builtin_amdgcn_rcpf(d.x); t.y = __builtin_amdgcn_rcpf(d.y);
    f32x2 q = t * 0.5307027145f + (-0.7265760135f); q = q * t + 0.7107068705f; q = q * t + (-0.142248368f); q = q * t + 0.127414796f; q = q * t;
    const f32x2 s = (v * v) * (-0.72134752044f);
    f32x2 e; e.x = __builtin_amdgcn_exp2f(s.x); e.y = __builtin_amdgcn_exp2f(s.y);
    const f32x2 m = v * (q * e), r = v - m;
    f32x2 o; o.x = v.x < 0.f ? m.x : r.x; o.y = v.y < 0.f ? m.y : r.y; return o;
}

template <int ACT  > struct EpiBf16 {
    static constexpr bool PERM = true, AFTER_DRAIN = false; static_assert(ACT == 0 || ACT == 1, "EpiBf16: ACT is 0 (none) or 1 (gelu_pk)");
    bf16_t* O; int ldc; const float* bias; int split_cols; size_t split_stride; float scale0;
    __device__ __forceinline__ void operator()(const f32x4 (&acc)[2][2][4][2], const Unit& u, int wr, int wc, int fr, int fq) const {
        const int row0 = u.pm * BM + wr * 64 + fr; int colt = u.pn * BM; bf16_t* base = O;
        float sc = 1.f; if (split_cols) { const int t = colt / split_cols; base += (size_t)t * split_stride; colt -= t * split_cols; if (t == 0) sc = scale0; }
        const int col0 = colt + wc * 32 + 8 * fq, bcol0 = u.pn * BM + wc * 32 + 8 * fq;
        f32x4 bv[2][2];
#pragma unroll
        for (int bj = 0; bj < 2; ++bj)
#pragma unroll
            for (int n = 0; n < 2; ++n) bv[bj][n] = bias ? *(const f32x4*)(bias + bcol0 + bj * HALF + 4 * n) : (f32x4){0.f, 0.f, 0.f, 0.f};
#pragma unroll
        for (int ai = 0; ai < 2; ++ai)
#pragma unroll
            for (int m = 0; m < 4; ++m) { bf16_t* rowp = base + (size_t)(row0 + ai * HALF + m * 16) * ldc + col0;
#pragma unroll
                for (int bj = 0; bj < 2; ++bj) { f32x4 v0 = acc[ai][bj][m][0] + bv[bj][0], v1 = acc[ai][bj][m][1] + bv[bj][1];
                    if (ACT == 1) { f32x2 a = gelu_pk((f32x2){v0[0], v0[1]}), b = gelu_pk((f32x2){v0[2], v0[3]}), c = gelu_pk((f32x2){v1[0], v1[1]}), d = gelu_pk((f32x2){v1[2], v1[3]});
                        v0 = (f32x4){a.x, a.y, b.x, b.y}; v1 = (f32x4){c.x, c.y, d.x, d.y}; }
                    v0 = v0 * sc; v1 = v1 * sc; u32x4 w; w.x = cvt_pk_bf16(v0[0], v0[1]); w.y = cvt_pk_bf16(v0[2], v0[3]); w.z = cvt_pk_bf16(v1[0], v1[1]); w.w = cvt_pk_bf16(v1[2], v1[3]);
                    *(u32x4*)(rowp + bj * HALF) = w; } }
    }
};
typedef unsigned u32x2 __attribute__((ext_vector_type(2)));
constexpr float RMS_EPS = 1e-6f;
__device__ __forceinline__ float row_rstd(const float* ssqp, int row, int fr_, int fq) {
    const f32x4 p = *(const f32x4*)(ssqp + (size_t)row * 16 + 4 * fq);
    float s = (p[0] + p[1]) + (p[2] + p[3]);
    const int ln_ = fr_ | (fq << 4); s += shfl_f(s, ln_ ^ 16); s += shfl_f(s, ln_ ^ 32);
    return rsqrtf(s * (1.0f / 1024.0f) + RMS_EPS);
}
__device__ __forceinline__ float fast_sigmoid(float x) { return __builtin_amdgcn_rcpf(1.0f + __expf(-x)); }
struct EpiProj {
    static constexpr bool PERM = true, AFTER_DRAIN = false;
    bf16_t* proj; float* small_; const PG8_LAS float* rtab;
    __device__ __forceinline__ void operator()(const f32x4 (&acc)[2][2][4][2], const Unit& u, int wr, int wc, int fr, int fq) const {
        const int row0 = u.pm * BM + wr * 64 + fr;
#pragma unroll
        for (int ai = 0; ai < 2; ++ai)
#pragma unroll
            for (int m = 0; m < 4; ++m) {
                const int row = row0 + ai * HALF + m * 16; const float rs = rtab[u.ord * BM + ai * HALF + wr * 64 + m * 16 + fr] * ((u.pn == 6) ? 0.25503486f : 1.0f);
                if (u.pn < 13) {
                    bf16_t* rowp = proj + (size_t)row * 3328 + u.pn * BM + wc * 32 + 8 * fq;
#pragma unroll
                    for (int bj = 0; bj < 2; ++bj) { const f32x4 v0 = acc[ai][bj][m][0] * rs, v1 = acc[ai][bj][m][1] * rs;
                        u32x4 w; w.x = cvt_pk_bf16(v0[0], v0[1]); w.y = cvt_pk_bf16(v0[2], v0[3]); w.z = cvt_pk_bf16(v1[0], v1[1]); w.w = cvt_pk_bf16(v1[2], v1[3]);
                        *(u32x4*)(rowp + bj * HALF) = w; }
                } else if (wc == 0 && fq < 2) {
                    float* sp = small_ + (size_t)row * 16 + 8 * fq;
                    *(f32x4*)sp = acc[ai][0][m][0] * rs; *(f32x4*)(sp + 4) = acc[ai][0][m][1] * rs;
                }
            }
    }
};
struct EpiGateUp {
    static constexpr bool PERM = true, AFTER_DRAIN = false;
    bf16_t* hid; const PG8_LAS float* rtab;
    __device__ __forceinline__ void operator()(const f32x4 (&acc)[2][2][4][2], const Unit& u, int wr, int wc, int fr, int fq) const {
        const int row0 = u.pm * BM + wr * 64 + fr;
#pragma unroll
        for (int ai = 0; ai < 2; ++ai)
#pragma unroll
            for (int m = 0; m < 4; ++m) {
                const int row = row0 + ai * HALF + m * 16; const float rs = rtab[u.ord * BM + ai * HALF + wr * 64 + m * 16 + fr];
                float h[8];
#pragma unroll
                for (int n = 0; n < 2; ++n)
#pragma unroll
                    for (int j = 0; j < 4; ++j) { const float g = acc[ai][0][m][n][j] * rs, up = acc[ai][1][m][n][j] * rs; h[4 * n + j] = g * fast_sigmoid(g) * up; }
                u32x4 w; w.x = cvt_pk_bf16(h[0], h[1]); w.y = cvt_pk_bf16(h[2], h[3]); w.z = cvt_pk_bf16(h[4], h[5]); w.w = cvt_pk_bf16(h[6], h[7]);
                *(u32x4*)(hid + (size_t)row * 2816 + u.pn * HALF + wc * 32 + 8 * fq) = w;
            }
    }
};
template <int MODE, bool BASEF32> struct EpiRes {
    static constexpr bool PERM = true, AFTER_DRAIN = false;
    const void* base; bf16_t* out; float* ssqp; const bf16_t* pp;
    __device__ __forceinline__ void operator()(const f32x4 (&acc)[2][2][4][2], const Unit& u, int wr, int wc, int fr, int fq) const {
        const int row0 = u.pm * BM + wr * 64 + fr, col0 = u.pn * BM + wc * 32 + 8 * fq;
#pragma unroll
        for (int ai = 0; ai < 2; ++ai)
#pragma unroll
            for (int m = 0; m < 4; ++m) {
                const int row = row0 + ai * HALF + m * 16; const size_t off = (size_t)row * 1024 + col0; float ss = 0.f;
                float b[2][8]; u32x4 pw[2];
#pragma unroll
                for (int bj = 0; bj < 2; ++bj) { const size_t o = off + bj * HALF;
                    if (BASEF32) { const f32x4 b0 = *(const f32x4*)((const float*)base + o), b1 = *(const f32x4*)((const float*)base + o + 4);
                        b[bj][0] = b0[0]; b[bj][1] = b0[1]; b[bj][2] = b0[2]; b[bj][3] = b0[3]; b[bj][4] = b1[0]; b[bj][5] = b1[1]; b[bj][6] = b1[2]; b[bj][7] = b1[3]; }
                    else { const u32x4 w = *(const u32x4*)((const bf16_t*)base + o);
#pragma unroll
                        for (int j = 0; j < 4; ++j) { b[bj][2 * j] = __uint_as_float(w[j] << 16); b[bj][2 * j + 1] = __uint_as_float(w[j] & 0xffff0000u); } }
                    if (MODE == 2) pw[bj] = *(const u32x4*)(pp + o); }
#pragma unroll
                for (int bj = 0; bj < 2; ++bj) { const size_t o = off + bj * HALF; float v[8];
#pragma unroll
                    for (int j = 0; j < 8; ++j) { float a = acc[ai][bj][m][j >> 2][j & 3];
                        if (MODE == 2) { const unsigned w = pw[bj][j >> 1]; a = fast_sigmoid(a) * __uint_as_float((j & 1) ? (w & 0xffff0000u) : (w << 16)); }
                        v[j] = b[bj][j] + a; ss += v[j] * v[j]; }
                    u32x4 hw; hw.x = cvt_pk_bf16(v[0], v[1]); hw.y = cvt_pk_bf16(v[2], v[3]); hw.z = cvt_pk_bf16(v[4], v[5]); hw.w = cvt_pk_bf16(v[6], v[7]);
                    *(u32x4*)(out + o) = hw; }
                if (MODE != 1) { const int ln_ = fr | (fq << 4); ss += shfl_f(ss, ln_ ^ 16); ss += shfl_f(ss, ln_ ^ 32); if (fq == 0) ssqp[(size_t)row * 16 + u.pn * 4 + wc] = ss; }
            }
    }
};
template <class Epi, class Sched, bool ALIGN_EPI = false, bool SP2 = false>
__device__ __forceinline__ void gemm_phase(const int wave_s, PG8_LAS unsigned char* lds, const Gemm g, const Sched& S, const Epi& E) {
    const int tid_ = wave_s * 64 + lane_id_asm();
    const int tid = tid_, wid = __builtin_amdgcn_readfirstlane(tid >> 6), lane = tid & 63, wr = wid >> 2, wc = wid & 3, fr = lane & 15, fq = lane >> 4;
    const int K = g.K, nt = K / BK;
    unsigned voffA[2], voffB[2];
#pragma unroll
    for (int i = 0; i < 2; ++i) { int R, C; stage_rc(tid * 16 + i * 8192, R, C); const int Rb = Epi::PERM ? ((R & ~31) + perm32(R & 31)) : R;
        voffA[i] = (unsigned)(R * K + C) * 2u; voffB[i] = (unsigned)(Rb * K + C) * 2u; }
    const size_t kstep = (size_t)(BK * 2);
    const size_t hstep = (size_t)HALF * K * 2;
    const size_t tstep = 2 * hstep;
    const unsigned ldsw = (unsigned)wid * 1024u;
    const int aoff = lds_byte(wr * 64 + fr, fq * 8), boff = lds_byte(wc * 32 + fr, fq * 8);
#define PG8_SA(b, h) (((b) * 2 + (h)) * HTB)
#define PG8_SB(b, h) ((4 + (b) * 2 + (h)) * HTB)
#define PG8_STAGE(bufoff, gbase, voff) do { _Pragma("unroll") for (int _i = 0; _i < 2; ++_i) \
        __builtin_amdgcn_global_load_lds((const unsigned*)((const char*)(gbase) + (voff)[_i]), (PG8_LAS unsigned*)(lds + (bufoff) + ldsw + _i * 8192), 16, 0, 0); } while (0)
#define PG8_LDA(dst, b, h) do { _Pragma("unroll") for (int m = 0; m < 4; ++m) _Pragma("unroll") for (int k = 0; k < 2; ++k) dst[m][k] = *(const PG8_LAS bf16x8*)(lds + PG8_SA(b, h) + aoff + m * 2048 + k * 1024); } while (0)
#define PG8_LDB(dst, b, h) do { _Pragma("unroll") for (int n = 0; n < 2; ++n) _Pragma("unroll") for (int k = 0; k < 2; ++k) dst[n][k] = *(const PG8_LAS bf16x8*)(lds + PG8_SB(b, h) + boff + n * 2048 + k * 1024); } while (0)
#define PG8_MMA(ai, bj, At, Bt) do { __builtin_amdgcn_s_setprio(1); _Pragma("unroll") for (int m = 0; m < 4; ++m) _Pragma("unroll") for (int n = 0; n < 2; ++n) _Pragma("unroll") for (int k = 0; k < 2; ++k) \
        acc[ai][bj][m][n] = __builtin_amdgcn_mfma_f32_16x16x32_bf16(Bt[n][k], At[m][k], acc[ai][bj][m][n], 0, 0, 0); __builtin_amdgcn_s_setprio(0); } while (0)
#define PG8_WAIT_V(n) asm volatile("s_waitcnt vmcnt(" #n ")" ::: "memory")
#define PG8_WAIT_L(n) asm volatile("s_waitcnt lgkmcnt(" #n ")" ::: "memory")
#define PG8_BAR __builtin_amdgcn_s_barrier()
#define PG8_SCHED __builtin_amdgcn_sched_barrier(0)
    Unit cur, nxt; int ui = 0;
    if (!S.next(0, cur)) return;
    cur.ord = 0;
    f32x4 acc[2][2][4][2];
#pragma unroll
    for (int a = 0; a < 2; ++a)
#pragma unroll
        for (int b = 0; b < 2; ++b)
#pragma unroll
            for (int m = 0; m < 4; ++m)
#pragma unroll
                for (int n = 0; n < 2; ++n) acc[a][b][m][n] = (f32x4){0.f, 0.f, 0.f, 0.f};
    bf16x8 At[4][2], B0[2][2], B1[2][2];
    const char* cA = (const char*)g.A + (size_t)cur.pm * tstep; const char* cB = (const char*)g.Bt + (size_t)cur.pn * tstep;
    S.a_ready(cur);
    if constexpr (SP2) {
        PG8_STAGE(PG8_SB(0, 0), cB, voffB); PG8_STAGE(PG8_SB(0, 1), cB + hstep, voffB); PG8_STAGE(PG8_SA(0, 0), cA, voffA); PG8_STAGE(PG8_SA(0, 1), cA + hstep, voffA);
        if (wr == 1) PG8_BAR;
        PG8_WAIT_V(2); PG8_BAR;
        PG8_STAGE(PG8_SB(1, 0), cB + kstep, voffB); PG8_STAGE(PG8_SA(1, 0), cA + kstep, voffA); PG8_STAGE(PG8_SB(1, 1), cB + hstep + kstep, voffB);
        PG8_WAIT_V(6); PG8_BAR;
    } else {
        PG8_STAGE(PG8_SB(0, 0), cB, voffB); PG8_STAGE(PG8_SA(0, 0), cA, voffA); PG8_STAGE(PG8_SB(0, 1), cB + hstep, voffB); PG8_STAGE(PG8_SA(0, 1), cA + hstep, voffA);
        if (wr == 1) PG8_BAR;
        PG8_WAIT_V(4); PG8_BAR;
        PG8_STAGE(PG8_SB(1, 0), cB + kstep, voffB); PG8_STAGE(PG8_SA(1, 0), cA + kstep, voffA); PG8_STAGE(PG8_SB(1, 1), cB + hstep + kstep, voffB);
        PG8_WAIT_V(6); PG8_BAR;
    }
    for (;;) {
        const bool has_next = S.next(ui + 1, nxt); nxt.ord = ui + 1;
        const char* nA = has_next ? (const char*)g.A + (size_t)nxt.pm * tstep : cA; const char* nB = has_next ? (const char*)g.Bt + (size_t)nxt.pn * tstep : cB;
        for (int t = 0; t < nt; t += 2) {
            const bool last = (t == nt - 2);
            const char* a1 = cA + (size_t)(t + 1) * kstep;
            const char* a2 = last ? nA : cA + (size_t)(t + 2) * kstep; const char* b2 = last ? nB : cB + (size_t)(t + 2) * kstep;
            const char* a3 = a2 + kstep; const char* b3 = b2 + kstep;
            if (last && has_next) S.a_ready(nxt);
            if constexpr (SP2) {
            PG8_LDB(B0, 0, 0); PG8_LDB(B1, 0, 1); PG8_SCHED; PG8_LDA(At, 0, 0); PG8_STAGE(PG8_SA(1, 1), a1 + hstep, voffA);
            PG8_WAIT_V(8); PG8_WAIT_L(0); PG8_BAR; PG8_MMA(0, 0, At, B0); PG8_MMA(0, 1, At, B1); PG8_BAR; PG8_SCHED;
            PG8_LDA(At, 0, 1); PG8_STAGE(PG8_SB(0, 0), b2, voffB); PG8_STAGE(PG8_SB(0, 1), b2 + hstep, voffB); PG8_STAGE(PG8_SA(0, 0), a2, voffA);
            PG8_WAIT_V(8); PG8_WAIT_L(0); PG8_BAR; PG8_MMA(1, 0, At, B0); PG8_MMA(1, 1, At, B1); PG8_BAR; PG8_SCHED;
            PG8_LDB(B0, 1, 0); PG8_LDB(B1, 1, 1); PG8_SCHED; PG8_LDA(At, 1, 0); PG8_STAGE(PG8_SA(0, 1), a2 + hstep, voffA);
            PG8_WAIT_V(8); PG8_WAIT_L(0); PG8_BAR; PG8_MMA(0, 0, At, B0); PG8_MMA(0, 1, At, B1); PG8_BAR; PG8_SCHED;
            PG8_LDA(At, 1, 1); PG8_STAGE(PG8_SB(1, 0), b3, voffB); PG8_STAGE(PG8_SB(1, 1), b3 + hstep, voffB); PG8_STAGE(PG8_SA(1, 0), a3, voffA);
            PG8_WAIT_V(8); PG8_WAIT_L(0); PG8_BAR; PG8_MMA(1, 0, At, B0); PG8_MMA(1, 1, At, B1); PG8_BAR; PG8_SCHED;
            } else {
            PG8_LDB(B0, 0, 0); PG8_SCHED; PG8_LDA(At, 0, 0); PG8_STAGE(PG8_SA(1, 1), a1 + hstep, voffA);
            PG8_WAIT_L(8); PG8_BAR; PG8_WAIT_L(0); PG8_MMA(0, 0, At, B0); PG8_BAR; PG8_SCHED;
            PG8_LDB(B1, 0, 1); PG8_STAGE(PG8_SB(0, 0), b2, voffB);
            PG8_BAR; PG8_WAIT_L(0); PG8_MMA(0, 1, At, B1); PG8_BAR;
            PG8_LDA(At, 0, 1); PG8_STAGE(PG8_SA(0, 0), a2, voffA);
            PG8_BAR; PG8_WAIT_L(0); PG8_MMA(1, 0, At, B0); PG8_BAR; PG8_SCHED;
            PG8_STAGE(PG8_SB(0, 1), b2 + hstep, voffB);
            PG8_WAIT_V(6); PG8_BAR; PG8_MMA(1, 1, At, B1); PG8_BAR;
            PG8_LDB(B0, 1, 0); PG8_SCHED; PG8_LDA(At, 1, 0); PG8_STAGE(PG8_SA(0, 1), a2 + hstep, voffA);
            PG8_WAIT_L(8); PG8_BAR; PG8_WAIT_L(0); PG8_MMA(0, 0, At, B0); PG8_BAR; PG8_SCHED;
            PG8_LDB(B1, 1, 1); PG8_STAGE(PG8_SB(1, 0), b3, voffB);
            PG8_BAR; PG8_WAIT_L(0); PG8_MMA(0, 1, At, B1); PG8_BAR;
            PG8_LDA(At, 1, 1); PG8_STAGE(PG8_SA(1, 0), a3, voffA);
            PG8_BAR; PG8_WAIT_L(0); PG8_MMA(1, 0, At, B0); PG8_BAR; PG8_SCHED;
            PG8_STAGE(PG8_SB(1, 1), b3 + hstep, voffB);
            PG8_WAIT_V(6); PG8_BAR; PG8_MMA(1, 1, At, B1); PG8_BAR;
            }
        }
        if constexpr (ALIGN_EPI) { if (wr == 0) PG8_BAR; }
        if constexpr (!Epi::AFTER_DRAIN) { const int l2_ = lane_id_asm(); E(acc, cur, wr, wc, l2_ & 15, l2_ >> 4); S.done(cur); }
        if (!has_next) break;
#pragma unroll
        for (int a = 0; a < 2; ++a)
#pragma unroll
            for (int b = 0; b < 2; ++b)
#pragma unroll
                for (int m = 0; m < 4; ++m)
#pragma unroll
                    for (int n = 0; n < 2; ++n) acc[a][b][m][n] = (f32x4){0.f, 0.f, 0.f, 0.f};
        cur = nxt; cA = nA; cB = nB; ++ui;
        if constexpr (ALIGN_EPI) { if (wr == 1) PG8_BAR; }
    }
    PG8_WAIT_V(0);
    if constexpr (!ALIGN_EPI) { if (wr == 0) PG8_BAR; }
    PG8_BAR;
    if constexpr (Epi::AFTER_DRAIN) { E.fused(acc, cur, wr, wc, fr, fq, lds, wid, lane); S.done(cur); }
#undef PG8_SA
#undef PG8_SB
#undef PG8_STAGE
#undef PG8_LDA
#undef PG8_LDB
#undef PG8_MMA
#undef PG8_WAIT_V
#undef PG8_WAIT_L
#undef PG8_BAR
#undef PG8_SCHED
}
}
#define GAS __attribute__((address_space(1)))
#define LAS __attribute__((address_space(3)))
typedef unsigned v4u __attribute__((ext_vector_type(4)));
typedef float f32x4 __attribute__((ext_vector_type(4)));
#define XB_TMO      128
#define XB_XCNT(j)  (256  + 64 * (j))
#define XB_XSUB(j)  (1280 + 64 * (j))
#define XB_XGEN(j)  (2304 + 64 * (j))
#define XB_TOP      3328
#define XB_TOPGEN   3392
#define XCD_BAR_WORDS 3456
#define XB_SPIN_CAP (1u << 18)

__device__ __forceinline__ unsigned xb_ld(unsigned* p)              { return __hip_atomic_load(p, __ATOMIC_RELAXED, __HIP_MEMORY_SCOPE_AGENT); }
__device__ __forceinline__ unsigned xb_add(unsigned* p, unsigned v) { return __hip_atomic_fetch_add(p, v, __ATOMIC_RELAXED, __HIP_MEMORY_SCOPE_AGENT); }
__device__ __forceinline__ unsigned xb_xcc_id() { return (unsigned)__builtin_amdgcn_s_getreg((3 << 11) | 20) & 0xFu; }
#define XB_SPIN(cond, bar) do { unsigned _sp = 0; while (cond) { __builtin_amdgcn_s_sleep(1); \
    if ((++_sp & 255u) == 0u) { if (xb_ld(&(bar)[XB_TMO])) break; if (_sp > XB_SPIN_CAP) { atomicAdd(&(bar)[XB_TMO], 1u); break; } } } } while (0)

struct XcdBarrier {
    unsigned* bar; unsigned x;
    volatile LAS unsigned* st;
    int w;
};

__device__ __forceinline__ XcdBarrier xcd_barrier_post(unsigned* bar, volatile LAS unsigned* st, int w) {
    XcdBarrier b; b.bar = bar; b.x = xb_xcc_id(); b.st = st; b.w = w;
    if (w == 0 && lane_id_asm() == 0) (void)xb_add(&bar[XB_XCNT(b.x)], 1u);
    return b;
}
__device__ __forceinline__ void xcd_barrier_complete(unsigned* bar, unsigned x, unsigned& nloc, unsigned& nx) {
    const unsigned G = gridDim.x * gridDim.y * gridDim.z;
    unsigned sum, cnt, mine, sp = 0u;
    for (;;) {
        sum = 0u; cnt = 0u; mine = 0u;
#pragma unroll
        for (unsigned j = 0; j < 16; ++j) { const unsigned c = xb_ld(&bar[XB_XCNT(j)]); sum += c; cnt += (c > 0u) ? 1u : 0u; mine = (j == x) ? c : mine; }
        if (sum == G) break;
        __builtin_amdgcn_s_sleep(1);
        if ((++sp & 255u) == 0u) { if (xb_ld(&bar[XB_TMO])) break; if (sp > XB_SPIN_CAP) { atomicAdd(&bar[XB_TMO], 1u); break; } }
    }
    nloc = mine > 0u ? mine : 1u; nx = cnt > 0u ? cnt : 1u;
}

__device__ __forceinline__ void xcd_barrier(const XcdBarrier& b) {
    asm volatile("s_waitcnt vmcnt(0)" ::: "memory");
    __syncthreads();
    if (b.w == 0 && lane_id_asm() == 0) {
        unsigned* bar = b.bar;
        __builtin_amdgcn_s_waitcnt(0);
        unsigned nloc = b.st[0], nx = b.st[1];
        if (nloc == 0u) { xcd_barrier_complete(bar, b.x, nloc, nx); b.st[0] = nloc; b.st[1] = nx; }
        const unsigned old = xb_add(&bar[XB_XSUB(b.x)], 1u);
        const unsigned gen = old / nloc;
        if (old + 1u == (gen + 1u) * nloc) {
            __builtin_amdgcn_fence(__ATOMIC_RELEASE, "agent");
            asm volatile("s_waitcnt vmcnt(0)" ::: "memory");
            const unsigned og = xb_add(&bar[XB_TOP], 1u);
            const unsigned tg = og / nx;
            if (og + 1u == (tg + 1u) * nx) xb_add(&bar[XB_TOPGEN], 1u);
            else XB_SPIN(xb_ld(&bar[XB_TOPGEN]) == tg, bar);
            __builtin_amdgcn_fence(__ATOMIC_ACQUIRE, "agent");
            xb_add(&bar[XB_XGEN(b.x)], 1u);
            asm volatile("s_waitcnt vmcnt(0)" ::: "memory");
        } else {
            XB_SPIN(xb_ld(&bar[XB_XGEN(b.x)]) == gen, bar);
            __builtin_amdgcn_fence(__ATOMIC_ACQUIRE, "agent");
            asm volatile("s_waitcnt vmcnt(0)" ::: "memory");
        }
    }
    __syncthreads();
}
namespace mx {
typedef short bf16x8 __attribute__((ext_vector_type(8)));
typedef short s16x4 __attribute__((ext_vector_type(4)));
typedef float f32x16 __attribute__((ext_vector_type(16)));
typedef __bf16 bf16x2_t __attribute__((ext_vector_type(2)));
typedef float f32x2_t __attribute__((ext_vector_type(2)));
typedef unsigned u32x2m __attribute__((ext_vector_type(2)));
typedef LAS bf16* lbf;
typedef LAS float* lf32;
#define WG_BAR() __syncthreads()
#define LAUNDER(x) asm volatile("" : "+v"(x))
__device__ __forceinline__ int crow(int i, int h) { return (i & 3) + 8 * (i >> 2) + 4 * h; }
__device__ __forceinline__ unsigned cvt2(float lo, float hi) { f32x2_t v = {lo, hi}; bf16x2_t b = __builtin_convertvector(v, bf16x2_t); return __builtin_bit_cast(unsigned, b); }
__device__ __forceinline__ f32x16 zero16() { f32x16 z; for (int i = 0; i < 16; ++i) z[i] = 0.f; return z; }
typedef short v4i16_t __attribute__((ext_vector_type(4)));
__device__ __forceinline__ s16x4 tr4(lbf p) { return __builtin_bit_cast(s16x4, __builtin_amdgcn_ds_read_tr16_b64_v4i16((LAS v4i16_t*)p)); }
__device__ __forceinline__ bf16x8 frag_n(lbf img, int P, int row0, int k0, int lane) { return *(const LAS bf16x8*)(img + (row0 + (lane & 31)) * P + k0 + 8 * (lane >> 5)); }
__device__ __forceinline__ bf16x8 frag_tr(lbf img, int P, int k0, int col0, int lane) {
    const int l16 = lane & 15; lbf a = img + (k0 + 8 * (lane >> 5) + (l16 >> 2)) * P + col0 + 16 * ((lane >> 4) & 1) + 4 * (l16 & 3);
    const s16x4 lo = tr4(a), hi = tr4(a + 4 * P); return __builtin_shufflevector(lo, hi, 0, 1, 2, 3, 4, 5, 6, 7);
}
__device__ __forceinline__ bf16x8 frag_tp(lbf img, int P, int k0, int col0, int lane) {
    const int l16 = lane & 15; lbf a = img + (k0 + 4 * (lane >> 5) + (l16 >> 2)) * P + col0 + 16 * ((lane >> 4) & 1) + 4 * (l16 & 3);
    const s16x4 lo = tr4(a), hi = tr4(a + 8 * P); return __builtin_shufflevector(lo, hi, 0, 1, 2, 3, 4, 5, 6, 7);
}
template <bool ATR, bool BTR>
__device__ __forceinline__ void mma(f32x16& acc, lbf A, int PA, int a0, lbf B, int PB, int b0, int K, int lane) {
    for (int k0 = 0; k0 < K; k0 += 16) {
        const bf16x8 a = ATR ? frag_tr(A, PA, k0, a0, lane) : frag_n(A, PA, a0, k0, lane);
        const bf16x8 b = BTR ? frag_tr(B, PB, k0, b0, lane) : frag_n(B, PB, b0, k0, lane);
        acc = __builtin_amdgcn_mfma_f32_32x32x16_bf16(a, b, acc, 0, 0, 0);
    }
}
__device__ __forceinline__ v4u pack8(const float (&v)[8]) { return (v4u){cvt2(v[0], v[1]), cvt2(v[2], v[3]), cvt2(v[4], v[5]), cvt2(v[6], v[7])}; }
__device__ __forceinline__ void scan_add128(float& a, float& b, int lane) {
    const float pair = a + b; float x = pair;
#pragma unroll
    for (int o = 1; o < 64; o <<= 1) { const float y = shfl_f(x, lane - o); if (lane >= o) x += y; }
    const float excl = x - pair; a = excl + a; b = excl + pair;
}
__device__ __forceinline__ void scan_max128(float& a, float& b, int lane) {
    const float pair = fmaxf(a, b); float x = pair;
#pragma unroll
    for (int o = 1; o < 64; o <<= 1) { const float y = shfl_f(x, lane - o); if (lane >= o) x = fmaxf(x, y); }
    float excl = shfl_f(x, lane - 1); if (lane == 0) excl = -3.0e38f;
    a = fmaxf(excl, a); b = fmaxf(excl, pair);
}
__device__ __forceinline__ float wave_max(float v, int lane) {
#pragma unroll
    for (int o = 1; o < 64; o <<= 1) v = fmaxf(v, shfl_f(v, lane ^ o));
    return v;
}
__device__ __forceinline__ void unpack8(const v4u w, float (&f)[8]) {
#pragma unroll
    for (int j = 0; j < 4; ++j) { f[2 * j] = __uint_as_float(w[j] << 16); f[2 * j + 1] = __uint_as_float(w[j] & 0xffff0000u); }
}

struct MixCtx {
    const bf16* PROJ; const float* SMALL; bf16* MIX; unsigned char* ws; const float* const* in; int L; float* states; float* cloc; bf16* prev; bf16* cprev;
};
constexpr size_t MS_CD = 0;
constexpr size_t MS_G = 16384;
constexpr size_t MS_ML = 32768;
constexpr size_t MS_MP = 49152;
constexpr size_t MS_NL = 65536;

template <int NR, class F>
__device__ __forceinline__ void conv8(const bf16* raw, int s0  , int r0, const float* cw, const float* cb, int cc, F f) {
    float w[4][8], bias[8];
#pragma unroll
    for (int k = 0; k < 4; ++k) { const f32x4 a = *(const f32x4*)(cw + k * 1024 + cc), b = *(const f32x4*)(cw + k * 1024 + cc + 4);
        w[k][0] = a.x; w[k][1] = a.y; w[k][2] = a.z; w[k][3] = a.w; w[k][4] = b.x; w[k][5] = b.y; w[k][6] = b.z; w[k][7] = b.w; }
    { const f32x4 a = *(const f32x4*)(cb + cc), b = *(const f32x4*)(cb + cc + 4); bias[0] = a.x; bias[1] = a.y; bias[2] = a.z; bias[3] = a.w; bias[4] = b.x; bias[5] = b.y; bias[6] = b.z; bias[7] = b.w; }
    float win[3][8];
#pragma unroll
    for (int k = 0; k < 3; ++k) { const int rr = r0 - 3 + k;
        if (s0 + rr >= 0) { const v4u u = *(const v4u*)(raw + (ptrdiff_t)rr * PJ); unpack8(u, win[k]); }
        else {
#pragma unroll
            for (int j = 0; j < 8; ++j) win[k][j] = 0.f; } }
#pragma unroll
    for (int i = 0; i < NR; ++i) {
        float cur[8]; { const v4u u = *(const v4u*)(raw + (ptrdiff_t)(r0 + i) * PJ); unpack8(u, cur); }
        float v[8];
#pragma unroll
        for (int j = 0; j < 8; ++j) { const float a = bias[j] + w[0][j] * win[0][j] + w[1][j] * win[1][j] + w[2][j] * win[2][j] + w[3][j] * cur[j]; v[j] = a * __builtin_amdgcn_rcpf(1.0f + __expf(-a)); }
        f(r0 + i, v);
#pragma unroll
        for (int j = 0; j < 8; ++j) { win[0][j] = win[1][j]; win[1][j] = win[2][j]; win[2][j] = cur[j]; }
    }
}

__device__ __forceinline__ void ssd_scalars(const MixCtx& c, int t0, int hd, lf32 DT, lf32 ACS, int lane) {
    const float dtb = c.in[I_DTB][c.L * 8 + hd], A = -__expf(c.in[I_ALOG][c.L * 8 + hd]);
    const float d0 = softplus_fast(c.SMALL[(size_t)(t0 + 2 * lane) * 16 + SM_DT + hd] + dtb), d1 = softplus_fast(c.SMALL[(size_t)(t0 + 2 * lane + 1) * 16 + SM_DT + hd] + dtb);
    float a0 = d0 * A, a1 = d1 * A; scan_add128(a0, a1, lane);
    DT[2 * lane] = d0; DT[2 * lane + 1] = d1; ACS[2 * lane] = a0; ACS[2 * lane + 1] = a1;
}

__device__ __forceinline__ void ssd_states_unit(const MixCtx& c, int u, LAS unsigned char* lds, int wave, int lane) {
    const int g = u & 1, bc = u >> 1, t0 = bc * 128, s0 = (bc & 15) * 128, tid = wave * 64 + lane;
    lf32 DT = (lf32)lds, ACS = (lf32)(lds + 2048);
    lbf BL = (lbf)(lds + 4096), XS = (lbf)(lds + 4096 + 40960);
    float* STATES = c.states; float* CD = (float*)(c.ws + WS_MISC + MS_CD);
    WG_BAR();
    if (wave < 4) ssd_scalars(c, t0, g * 4 + wave, DT + wave * 128, ACS + wave * 128, lane);
    WG_BAR();
    {
        const int oct = tid & 63, seg = tid >> 6;
        const float* cw = c.in[I_CONVW] + c.L * 4096; const float* cb = c.in[I_CONVB] + c.L * 1024;
        if (oct < 16) { const int cc = 512 + g * 128 + 8 * oct;
            conv8<16>(c.PROJ + (size_t)t0 * PJ + O_XBC + cc, s0, seg * 16, cw, cb, cc, [&](int l, const float (&v)[8]) { *(LAS v4u*)(BL + l * 160 + 8 * oct) = pack8(v); });
        } else if (oct < 48) { const int o2 = oct - 16, h = o2 >> 3, cc = g * 256 + 8 * o2;
            const float aend = ACS[h * 128 + 127];
            conv8<16>(c.PROJ + (size_t)t0 * PJ + O_XBC + cc, s0, seg * 16, cw, cb, cc, [&](int l, const float (&v)[8]) {
                const float sc = DT[h * 128 + l] * __expf(aend - ACS[h * 128 + l]); float w[8];
#pragma unroll
                for (int j = 0; j < 8; ++j) w[j] = v[j] * sc;
                *(LAS v4u*)(XS + l * 288 + 8 * o2) = pack8(w); });
        }
    }
    WG_BAR();
    const int pi = wave >> 2, ni = wave & 3, r = lane & 31, hh = lane >> 5;
#pragma unroll 1
    for (int h = 0; h < 4; ++h) {
        f32x16 acc = zero16();
        mma<true, true>(acc, XS, 288, h * 64 + 32 * pi, BL, 160, 32 * ni, 128, lane);
        bf16* dst = (bf16*)STATES + ((size_t)(bc * 8 + g * 4 + h) * 64 + 32 * pi) * 128 + 32 * ni + r;
#pragma unroll
        for (int i = 0; i < 16; ++i) dst[(size_t)crow(i, hh) * 128] = f2bf(acc[i]);
    }
    if (tid < 4) CD[bc * 8 + g * 4 + tid] = __expf(ACS[tid * 128 + 127]);
}

__device__ __forceinline__ void ml_summary_unit(const MixCtx& c, int u, LAS unsigned char* lds, int wave, int lane) {
    const int h = u & 3, bc = u >> 2, t0 = bc * 128, tid = wave * 64 + lane;
    lf32 EE = (lf32)lds, NPART = (lf32)(lds + 512);
    lbf VS = (lbf)(lds + 2048), KS = (lbf)(lds + 2048 + 24576);
    float* CLOC = c.cloc; unsigned char* ms = c.ws + WS_MISC;
    WG_BAR();
    if (wave == 0) {
        const float ib = c.in[I_MIB][c.L * 4 + h], fb = c.in[I_MFB][c.L * 4 + h];
        const float li0 = c.SMALL[(size_t)(t0 + 2 * lane) * 16 + SM_MI + h] + ib, li1 = c.SMALL[(size_t)(t0 + 2 * lane + 1) * 16 + SM_MI + h] + ib;
        float b0 = logsigmoid_fast(c.SMALL[(size_t)(t0 + 2 * lane) * 16 + SM_MF + h] + fb), b1 = logsigmoid_fast(c.SMALL[(size_t)(t0 + 2 * lane + 1) * 16 + SM_MF + h] + fb);
        scan_add128(b0, b1, lane);
        const float gsum = shfl_f(b1, 63);
        const float w0 = gsum - b0 + li0, w1 = gsum - b1 + li1;
        const float ml = wave_max(fmaxf(w0, w1), lane);
        EE[2 * lane] = __expf(w0 - ml); EE[2 * lane + 1] = __expf(w1 - ml);
        if (lane == 0) { ((float*)(ms + MS_G))[u] = gsum; ((float*)(ms + MS_ML))[u] = ml; }
    }
    const int oct = tid & 7, r0 = tid >> 3;
    v4u vraw[2], kraw[2];
#pragma unroll
    for (int pass = 0; pass < 2; ++pass) { const bf16* row = c.PROJ + (size_t)(t0 + r0 + 64 * pass) * PJ + h * 64 + 8 * oct; vraw[pass] = *(const v4u*)(row + O_MV); kraw[pass] = *(const v4u*)(row + O_MK); }
    WG_BAR();
#pragma unroll
    for (int pass = 0; pass < 2; ++pass) { const int s = r0 + 64 * pass; float v[8], k[8]; unpack8(vraw[pass], v); unpack8(kraw[pass], k); const float e = EE[s];
#pragma unroll
        for (int j = 0; j < 8; ++j) { v[j] *= e; k[j] *= 0.125f; }
        *(LAS v4u*)(VS + s * 96 + 8 * oct) = pack8(v); *(LAS v4u*)(KS + s * 96 + 8 * oct) = pack8(k); }
    WG_BAR();
    if (wave < 4) {
        const int ei = wave >> 1, di = wave & 1, r = lane & 31, hh = lane >> 5;
        f32x16 acc = zero16();
        mma<true, true>(acc, VS, 96, 32 * ei, KS, 96, 32 * di, 128, lane);
        float* dst = CLOC + ((size_t)u * 64 + 32 * ei) * 64 + 32 * di + r;
#pragma unroll
        for (int i = 0; i < 16; ++i) dst[crow(i, hh) * 64] = acc[i];
    } else {
        const int part = wave - 4; float a = 0.f;
#pragma unroll 8
        for (int s = 32 * part; s < 32 * part + 32; ++s) a += EE[s] * bf2f(KS[s * 96 + lane]);
        NPART[part * 64 + lane] = a;
    }
    WG_BAR();
    if (wave == 4) ((float*)(ms + MS_NL))[(size_t)u * 64 + lane] = (NPART[lane] + NPART[64 + lane]) + (NPART[128 + lane] + NPART[192 + lane]);
}

__device__ __forceinline__ void scan_phase(const MixCtx& c, int G, int wave, int lane) {
    const int gt = blockIdx.x * NT + wave * 64 + lane, ngt = G * NT;
    const float* STATES = c.states; const float* CD = (const float*)(c.ws + WS_MISC + MS_CD);
    for (int e = gt; e < NB * 8 * 64 * 16; e += ngt) {
        const int n8 = e & 15, p = (e >> 4) & 63, hd = (e >> 10) & 7, b = e >> 13;
        const size_t base8 = ((size_t)((b * 16) * 8 + hd) * 64 + p) * 16 + n8;
        const v4u* sp = (const v4u*)STATES + base8; v4u* pp = (v4u*)c.prev + base8;
        v4u sv[16]; float cd[16];
#pragma unroll
        for (int ch = 0; ch < 16; ++ch) { sv[ch] = sp[(size_t)ch * 8192]; cd[ch] = CD[(b * 16 + ch) * 8 + hd]; }
        float run[8];
#pragma unroll
        for (int q = 0; q < 8; ++q) { run[q] = 0.f; LAUNDER(run[q]); }
#pragma unroll
        for (int ch = 0; ch < 16; ++ch) { pp[(size_t)ch * 8192] = pack8(run); float sf[8]; unpack8(sv[ch], sf);
#pragma unroll
            for (int q = 0; q < 8; ++q) run[q] = run[q] * cd[ch] + sf[q]; }
    }
    float* CLOC = c.cloc; unsigned char* ms = c.ws + WS_MISC;
    const float* Gs = (const float*)(ms + MS_G); const float* ML = (const float*)(ms + MS_ML); float* MP = (float*)(ms + MS_MP); float* NL = (float*)(ms + MS_NL);
    for (int e = gt; e < NB * 4 * 64 * 16 + NB * 4 * 16; e += ngt) {
        const bool isn = e >= NB * 4 * 64 * 16; const int e2 = isn ? e - NB * 4 * 64 * 16 : e;
        const int d4 = e2 & 15, er = isn ? 0 : (e2 >> 4) & 63, bh = isn ? (e2 >> 4) : (e2 >> 10), h = bh & 3, b = bh >> 2;
        const int u0 = (b * 16) * 4 + h;
        float gl[16], ml[16];
#pragma unroll
        for (int ch = 0; ch < 16; ++ch) { gl[ch] = Gs[u0 + 4 * ch]; ml[ch] = ML[u0 + 4 * ch]; }
        float z0 = 0.f; LAUNDER(z0); f32x4 run = {z0, z0, z0, z0}; float m = 0.f; f32x4 sv[16];
        if (!isn) {
            const f32x4* sp = (const f32x4*)(CLOC + ((size_t)u0 * 64 + er) * 64) + d4; u32x2m* cp = (u32x2m*)c.cprev + ((size_t)u0 * 64 + er) * 16 + d4;
#pragma unroll
            for (int ch = 0; ch < 16; ++ch) sv[ch] = sp[(size_t)ch * 4096];
#pragma unroll
            for (int ch = 0; ch < 16; ++ch) { const float mn = fmaxf(gl[ch] + m, ml[ch]), ap = __expf(gl[ch] + m - mn), al = __expf(ml[ch] - mn);
                cp[(size_t)ch * 4096] = (u32x2m){cvt2(run.x, run.y), cvt2(run.z, run.w)}; run = run * ap + sv[ch] * al; m = mn; }
        } else {
            f32x4* sp = (f32x4*)(NL + (size_t)u0 * 64) + d4;
#pragma unroll
            for (int ch = 0; ch < 16; ++ch) sv[ch] = sp[ch * 64];
#pragma unroll
            for (int ch = 0; ch < 16; ++ch) { const float mn = fmaxf(gl[ch] + m, ml[ch]), ap = __expf(gl[ch] + m - mn), al = __expf(ml[ch] - mn);
                sp[ch * 64] = run; if (d4 == 0) MP[u0 + 4 * ch] = m; run = run * ap + sv[ch] * al; m = mn; }
        }
    }
}

template <int VAR>
__device__ __forceinline__ void ssd_group(const MixCtx& c, int bc, int g, LAS unsigned char* lds, int wave, int lane_in, unsigned (&gp)[4][8], float& ssq) {
    const int t0 = bc * 128, s0 = (bc & 15) * 128;
    lf32 DT = (lf32)lds, ACS = (lf32)(lds + 2048);
    lbf CL = (lbf)(lds + 4096), BL = (lbf)(lds + 4096 + 34816), PV = (lbf)(lds + 4096 + 2 * 34816), XD = PV;
    const float* cw = c.in[I_CONVW] + c.L * 4096; const float* cb = c.in[I_CONVB] + c.L * 1024;
    {
        int lane = lane_in; LAUNDER(lane); const int tid = wave * 64 + lane, r = lane & 31, hh = lane >> 5;
        const int li = wave >> 1, ph = wave & 1, l = 32 * li + r;
        WG_BAR();
        {
            const v4u* src = (const v4u*)(c.prev + (size_t)(bc * 8 + g * 4) * 8192);
            v4u pvr[8];
#pragma unroll
            for (int k = 0; k < 8; ++k) pvr[k] = src[tid + 512 * k];
            if (wave < 4) ssd_scalars(c, t0, g * 4 + wave, DT + wave * 128, ACS + wave * 128, lane);
            {
                const int oct = tid & 31, seg = tid >> 5; const int cc = 512 + (oct >> 4) * 256 + g * 128 + 8 * (oct & 15);
                lbf dstm = (oct < 16) ? BL : CL;
                conv8<8>(c.PROJ + (size_t)t0 * PJ + O_XBC + cc, s0, seg * 8, cw, cb, cc, [&](int l2, const float (&v)[8]) { *(LAS v4u*)(dstm + l2 * 136 + 8 * (oct & 15)) = pack8(v); });
            }
#pragma unroll
            for (int k = 0; k < 8; ++k) { const int e = tid + 512 * k, pr = e >> 4, n8 = e & 15; *(LAS v4u*)(PV + pr * 136 + 8 * n8) = pvr[k]; }
        }
        WG_BAR();
        f32x16 ag[4];
#pragma unroll
        for (int h = 0; h < 4; ++h) { ag[h] = zero16();
            if (VAR >= 2) mma<false, false>(ag[h], PV, 136, h * 64 + 32 * ph, CL, 136, 32 * li, 128, lane);
            const float el = __expf(ACS[h * 128 + l]);
#pragma unroll
            for (int i = 0; i < 16; ++i) ag[h][i] *= el; }
        WG_BAR();
        if (VAR >= 3) {
            const int oct = tid & 31, seg = tid >> 5, h = oct >> 3, cc = g * 256 + 8 * oct;
            conv8<8>(c.PROJ + (size_t)t0 * PJ + O_XBC + cc, s0, seg * 8, cw, cb, cc, [&](int l2, const float (&v)[8]) {
                const float dt = DT[h * 128 + l2]; float w[8];
#pragma unroll
                for (int j = 0; j < 8; ++j) w[j] = v[j] * dt;
                *(LAS v4u*)(XD + l2 * 288 + 8 * oct) = pack8(w); });
        }
        WG_BAR();
#pragma unroll 1
        for (int si = 0; si <= (VAR >= 4 ? li : -1); ++si) {
            f32x16 cbT = zero16();
            mma<false, false>(cbT, BL, 136, 32 * si, CL, 136, 32 * li, 128, lane);
#pragma unroll
            for (int h = 0; h < 4; ++h) {
                const float al = ACS[h * 128 + l]; float p[16];
                float as_[16];
#pragma unroll
                for (int i = 0; i < 16; ++i) as_[i] = ACS[h * 128 + 32 * si + crow(i, hh)];
#pragma unroll
                for (int i = 0; i < 16; ++i) { const int s = 32 * si + crow(i, hh); const float w = cbT[i] * __expf(fminf(al - as_[i], 0.f)); p[i] = (si < li || s <= l) ? w : 0.f; }
#pragma unroll
                for (int s2 = 0; s2 < 2; ++s2) {
                    const v4u pw = {cvt2(p[8 * s2], p[8 * s2 + 1]), cvt2(p[8 * s2 + 2], p[8 * s2 + 3]), cvt2(p[8 * s2 + 4], p[8 * s2 + 5]), cvt2(p[8 * s2 + 6], p[8 * s2 + 7])};
                    ag[h] = __builtin_amdgcn_mfma_f32_32x32x16_bf16(frag_tp(XD, 288, 32 * si + 16 * s2, h * 64 + 32 * ph, lane), __builtin_bit_cast(bf16x8, pw), ag[h], 0, 0, 0);
                }
            }
        }
#pragma unroll
        for (int h = 0; h < 4; ++h) {
            const float dsk = c.in[I_SSDD][c.L * 8 + g * 4 + h] / fmaxf(DT[h * 128 + l], 1e-20f);
            lbf xrow = XD + l * 288 + h * 64 + 32 * ph + 4 * hh;
#pragma unroll
            for (int gq = 0; gq < 4; ++gq) { const u32x2m xw = *(const LAS u32x2m*)(xrow + 8 * gq);
                ag[h][4 * gq] += __uint_as_float(xw.x << 16) * dsk; ag[h][4 * gq + 1] += __uint_as_float(xw.x & 0xffff0000u) * dsk;
                ag[h][4 * gq + 2] += __uint_as_float(xw.y << 16) * dsk; ag[h][4 * gq + 3] += __uint_as_float(xw.y & 0xffff0000u) * dsk; }
        }
        WG_BAR();
        lbf ZG = (lbf)(lds + 4096);
        {
            v4u zv[8];
#pragma unroll
            for (int k = 0; k < 8; ++k) { const int e = tid + 512 * k; zv[k] = *(const v4u*)(c.PROJ + (size_t)(t0 + (e >> 5)) * PJ + O_Z + g * 256 + 8 * (e & 31)); }
#pragma unroll
            for (int k = 0; k < 8; ++k) { const int e = tid + 512 * k; LAS u32x2m* d = (LAS u32x2m*)(ZG + (e >> 5) * 260 + 8 * (e & 31)); d[0] = (u32x2m){zv[k].x, zv[k].y}; d[1] = (u32x2m){zv[k].z, zv[k].w}; }
        }
        WG_BAR();
#pragma unroll
        for (int h = 0; h < 4; ++h) { lbf zrow = ZG + l * 260 + h * 64 + 32 * ph + 4 * hh;
#pragma unroll
            for (int gq = 0; gq < 4; ++gq) { const u32x2m zw = *(const LAS u32x2m*)(zrow + 8 * gq);
                const float z4[4] = {__uint_as_float(zw.x << 16), __uint_as_float(zw.x & 0xffff0000u), __uint_as_float(zw.y << 16), __uint_as_float(zw.y & 0xffff0000u)}; float o4[4];
#pragma unroll
                for (int k = 0; k < 4; ++k) { o4[k] = ag[h][4 * gq + k] * z4[k] * __builtin_amdgcn_rcpf(1.0f + __expf(-z4[k])); ssq += o4[k] * o4[k]; }
                gp[h][2 * gq] = cvt2(o4[0], o4[1]); gp[h][2 * gq + 1] = cvt2(o4[2], o4[3]); } }
    }
}
template <int VAR = 9>
__device__ __forceinline__ void ssd_out_unit(const MixCtx& c, int bc, LAS unsigned char* lds, int wave, int lane_in) {
    const int t0 = bc * 128;
    lf32 SQ = (lf32)lds;
    lbf ZT = (lbf)(lds + 4096);
    unsigned g0[4][8], g1[4][8]; float ss = 0.f;
#pragma unroll
    for (int a_ = 0; a_ < 4; ++a_)
#pragma unroll
        for (int b_ = 0; b_ < 8; ++b_) { g0[a_][b_] = 0u; g1[a_][b_] = 0u; }
#pragma unroll 1
    for (int g = 0; g < 2; ++g) {
        unsigned gp[4][8];
        ssd_group<VAR>(c, bc, g, lds, wave, lane_in, gp, ss);
#pragma unroll
        for (int a_ = 0; a_ < 4; ++a_)
#pragma unroll
            for (int b_ = 0; b_ < 8; ++b_) { if (g == 0) g0[a_][b_] = gp[a_][b_]; else g1[a_][b_] = gp[a_][b_]; }
    }
    if (VAR < 5) return;
    int lane = lane_in; LAUNDER(lane); const int tid = wave * 64 + lane, r = lane & 31, hh = lane >> 5;
    const int li = wave >> 1, ph = wave & 1, l = 32 * li + r;
    (void)ss; (void)SQ;
    WG_BAR();
#pragma unroll
    for (int h = 0; h < 8; ++h) { lbf orow = ZT + l * 516 + h * 64 + 32 * ph + 4 * hh;
#pragma unroll
        for (int gq = 0; gq < 4; ++gq) { const unsigned p0 = (h < 4) ? g0[h & 3][2 * gq] : g1[h & 3][2 * gq], p1 = (h < 4) ? g0[h & 3][2 * gq + 1] : g1[h & 3][2 * gq + 1];
            *(LAS u32x2m*)(orow + 8 * gq) = (u32x2m){p0, p1}; } }
    WG_BAR();
    {
        const float* nw = c.in[I_SSDNW] + c.L * 512;
        float wv[8]; { const f32x4 a = *(const f32x4*)(nw + 8 * lane), b = *(const f32x4*)(nw + 8 * lane + 4); wv[0] = a.x; wv[1] = a.y; wv[2] = a.z; wv[3] = a.w; wv[4] = b.x; wv[5] = b.y; wv[6] = b.z; wv[7] = b.w; }
#pragma unroll 4
        for (int k = 0; k < 16; ++k) { const int row = wave * 16 + k; const LAS u32x2m* sp = (const LAS u32x2m*)(ZT + row * 516 + 8 * lane);
            const u32x2m a = sp[0], b = sp[1]; float v[8]; unpack8((v4u){a.x, a.y, b.x, b.y}, v); float s2 = 0.f;
#pragma unroll
            for (int j2 = 0; j2 < 8; ++j2) s2 += v[j2] * v[j2];
            const float rs = rsqrtf(wave_sum_l(s2, lane) * (1.f / 512.f) + EPS);
#pragma unroll
            for (int j2 = 0; j2 < 8; ++j2) v[j2] *= rs * wv[j2];
            *(v4u*)(c.MIX + (size_t)(t0 + row) * 1024 + 8 * lane) = pack8(v); }
    }
}

__device__ __forceinline__ void ml_out_unit(const MixCtx& c, int u, LAS unsigned char* lds, int wave, int lane) {
    const int h = u & 3, bc = u >> 2, t0 = bc * 128, tid = wave * 64 + lane;
    lf32 RM = (lf32)lds, U = (lf32)(lds + 512), MT = (lf32)(lds + 1024), WI = (lf32)(lds + 1536), DEN = (lf32)(lds + 2048), NP = (lf32)(lds + 2560);
    lbf Q = (lbf)(lds + 4096), Kk = (lbf)(lds + 22528), VS = (lbf)(lds + 40960), CP = (lbf)(lds + 65536), AM = (lbf)(lds + 74752);
    lf32 HBf = (lf32)(lds + 4096);
    const unsigned char* ms = c.ws + WS_MISC;
    WG_BAR();
    if (wave == 0) {
        const float ib = c.in[I_MIB][c.L * 4 + h], fb = c.in[I_MFB][c.L * 4 + h];
        const float li0 = c.SMALL[(size_t)(t0 + 2 * lane) * 16 + SM_MI + h] + ib, li1 = c.SMALL[(size_t)(t0 + 2 * lane + 1) * 16 + SM_MI + h] + ib;
        float b0 = logsigmoid_fast(c.SMALL[(size_t)(t0 + 2 * lane) * 16 + SM_MF + h] + fb), b1 = logsigmoid_fast(c.SMALL[(size_t)(t0 + 2 * lane + 1) * 16 + SM_MF + h] + fb);
        scan_add128(b0, b1, lane);
        const float u0 = li0 - b0, u1 = li1 - b1; float p0 = u0, p1 = u1; scan_max128(p0, p1, lane);
        const float mp = ((const float*)(ms + MS_MP))[u];
        const float in0 = b0 + mp, in1 = b1 + mp, mt0 = fmaxf(in0, b0 + p0), mt1 = fmaxf(in1, b1 + p1);
        U[2 * lane] = u0; U[2 * lane + 1] = u1; RM[2 * lane] = b0 - mt0; RM[2 * lane + 1] = b1 - mt1; MT[2 * lane] = mt0; MT[2 * lane + 1] = mt1;
        WI[2 * lane] = __expf(in0 - mt0); WI[2 * lane + 1] = __expf(in1 - mt1);
        NP[lane] = ((const float*)(ms + MS_NL))[(size_t)u * 64 + lane];
    }
    {
        const int oct = tid & 7, r0 = tid >> 3;
#pragma unroll
        for (int pass = 0; pass < 2; ++pass) { const int s = r0 + 64 * pass; const bf16* row = c.PROJ + (size_t)(t0 + s) * PJ + h * 64 + 8 * oct;
            *(LAS v4u*)(Q + s * 72 + 8 * oct) = *(const v4u*)(row + O_MQ);
            float k[8]; unpack8(*(const v4u*)(row + O_MK), k);
            *(LAS v4u*)(Kk + s * 72 + 8 * oct) = (v4u){cvt2(k[0] * 0.125f, k[1] * 0.125f), cvt2(k[2] * 0.125f, k[3] * 0.125f), cvt2(k[4] * 0.125f, k[5] * 0.125f), cvt2(k[6] * 0.125f, k[7] * 0.125f)};
            *(LAS v4u*)(VS + s * 96 + 8 * oct) = *(const v4u*)(row + O_MV); }
        *(LAS v4u*)(CP + (tid >> 3) * 72 + 8 * (tid & 7)) = ((const v4u*)(c.cprev + (size_t)u * 4096))[tid];
    }
    WG_BAR();
    const int r = lane & 31, hh = lane >> 5;
#pragma unroll
    for (int q = 0; q < 2; ++q) { const int id = wave + 8 * q;
        if (id < 10) { int li = 0, si = 0; { int rem = id; for (li = 0; li < 4; ++li) { if (rem <= li) { si = rem; break; } rem -= li + 1; } }
            f32x16 acc = zero16();
            mma<false, false>(acc, Q, 72, 32 * li, Kk, 72, 32 * si, 64, lane);
            const int scol = 32 * si + r; const float us = U[scol]; float rm[16];
#pragma unroll
            for (int i = 0; i < 16; ++i) rm[i] = RM[32 * li + crow(i, hh)];
#pragma unroll
            for (int i = 0; i < 16; ++i) { const int l = 32 * li + crow(i, hh); const float w = acc[i] * __expf(fminf(rm[i] + us, 0.f)); AM[l * 136 + scol] = f2bf((scol <= l) ? w : 0.f); } } }
    WG_BAR();
    {
        const int l = tid >> 2, part = tid & 3; float a = 0.f;
        if (32 * part <= l) {
#pragma unroll
            for (int k = 0; k < 4; ++k) { float v[8]; unpack8(*(const LAS v4u*)(AM + l * 136 + 32 * part + 8 * k), v);
#pragma unroll
                for (int j = 0; j < 8; ++j) a += (32 * part + 8 * k + j <= l) ? v[j] : 0.f; } }
        float qn = 0.f;
#pragma unroll
        for (int k = 0; k < 2; ++k) { float v[8]; unpack8(*(const LAS v4u*)(Q + l * 72 + 16 * part + 8 * k), v);
#pragma unroll
            for (int j = 0; j < 8; ++j) qn += v[j] * NP[16 * part + 8 * k + j]; }
        a += WI[l] * qn; a += shfl_f(a, lane ^ 1); a += shfl_f(a, lane ^ 2);
        if (part == 0) DEN[l] = fmaxf(fabsf(a), __expf(-MT[l]));
    }
    WG_BAR();
    {
        const int li = wave >> 1, ei = wave & 1;
        f32x16 acc = zero16();
        mma<false, false>(acc, Q, 72, 32 * li, CP, 72, 32 * ei, 64, lane);
#pragma unroll
        for (int i = 0; i < 16; ++i) acc[i] *= WI[32 * li + crow(i, hh)];
        mma<false, true>(acc, AM, 136, 32 * li, VS, 96, 32 * ei, 32 * (li + 1), lane);
        WG_BAR();
#pragma unroll
        for (int i = 0; i < 16; ++i) { const int l = 32 * li + crow(i, hh); HBf[l * 68 + 32 * ei + r] = acc[i] / DEN[l]; }
    }
    WG_BAR();
    {
        const int l = tid >> 2, part = tid & 3; const float* nw = c.in[I_MNW] + c.L * 256 + h * 64 + 16 * part;
        float v[16]; float s = 0.f;
#pragma unroll
        for (int k = 0; k < 4; ++k) { const f32x4 x = *(const LAS f32x4*)(HBf + l * 68 + 16 * part + 4 * k); v[4 * k] = x.x; v[4 * k + 1] = x.y; v[4 * k + 2] = x.z; v[4 * k + 3] = x.w; s += (x.x * x.x + x.y * x.y) + (x.z * x.z + x.w * x.w); }
        s += shfl_f(s, lane ^ 1); s += shfl_f(s, lane ^ 2);
        const float rs = rsqrtf(s * (1.f / 64.f) + EPS);
        const bf16* orow = c.PROJ + (size_t)(t0 + l) * PJ + O_MO + h * 64 + 16 * part; bf16* dst = c.MIX + (size_t)(t0 + l) * 1024 + 768 + h * 64 + 16 * part;
#pragma unroll
        for (int k = 0; k < 2; ++k) { float o[8]; unpack8(*(const v4u*)(orow + 8 * k), o); float y[8];
#pragma unroll
            for (int j = 0; j < 8; ++j) y[j] = __builtin_amdgcn_rcpf(1.0f + __expf(-o[j])) * v[8 * k + j] * rs * nw[8 * k + j];
            *(v4u*)(dst + 8 * k) = (v4u){cvt2(y[0], y[1]), cvt2(y[2], y[3]), cvt2(y[4], y[5]), cvt2(y[6], y[7])}; }
    }
}

typedef unsigned u32x2p __attribute__((ext_vector_type(2)));
__device__ __forceinline__ float xhalf_max(float v) { const u32x2p r = __builtin_amdgcn_permlane32_swap(__float_as_uint(v), __float_as_uint(v), false, false); return fmaxf(__uint_as_float(r.x), __uint_as_float(r.y)); }
__device__ __forceinline__ float xhalf_sum(float v) { const u32x2p r = __builtin_amdgcn_permlane32_swap(__float_as_uint(v), __float_as_uint(v), false, false); return __uint_as_float(r.x) + __uint_as_float(r.y); }
struct AttnTile { f32x16 s; bool far; };
__device__ __forceinline__ void attn_qk(AttnTile& t, lbf KS, int kt, int m, const bf16x8 (&qf)[2], int lane) {
    lbf kp = KS + (kt * 32 + (lane & 31)) * 72 + m * 32 + 8 * (lane >> 5);
    t.s = zero16();
    t.s = __builtin_amdgcn_mfma_f32_32x32x16_bf16(*(const LAS bf16x8*)kp, qf[0], t.s, 0, 0, 0);
    t.s = __builtin_amdgcn_mfma_f32_32x32x16_bf16(*(const LAS bf16x8*)(kp + 16), qf[1], t.s, 0, 0, 0);
}
__device__ __forceinline__ float attn_tmax(AttnTile& t, float c1, lf32 RL, int qpos, int k0, int hh, bool diag) {
    if (t.far) { float mt = t.s[0];
#pragma unroll
        for (int i = 1; i < 16; ++i) mt = fmaxf(mt, t.s[i]);
        return mt * c1 + RL[64]; }
    float mt = -1e30f;
    lf32 rb = RL + (191 - qpos + k0 + 4 * hh);
    float bias[16];
#pragma unroll
    for (int i = 0; i < 16; ++i) bias[i] = rb[(i & 3) + 8 * (i >> 2)];
    if (diag) {
#pragma unroll
        for (int i = 0; i < 16; ++i) { const float v = (k0 + crow(i, hh) <= qpos) ? t.s[i] * c1 + bias[i] : -1e30f; t.s[i] = v; mt = fmaxf(mt, v); }
    } else {
#pragma unroll
        for (int i = 0; i < 16; ++i) { const float v = t.s[i] * c1 + bias[i]; t.s[i] = v; mt = fmaxf(mt, v); }
    }
    return mt;
}
__device__ __forceinline__ float attn_probs(AttnTile& t, float c1, lf32 LUT, float mn) {
    float ps = 0.f;
    if (t.far) { const float cbm = LUT[64] - mn;
#pragma unroll
        for (int i = 0; i < 16; ++i) { t.s[i] = __builtin_amdgcn_exp2f(t.s[i] * c1 + cbm); ps += t.s[i]; }
    } else {
#pragma unroll
        for (int i = 0; i < 16; ++i) { t.s[i] = __builtin_amdgcn_exp2f(t.s[i] - mn); ps += t.s[i]; }
    }
    return ps;
}
__device__ __forceinline__ void attn_pv(const AttnTile& t, lbf VS, int krow0, f32x16& o0, f32x16& o1, int lane) {
#pragma unroll
    for (int s2 = 0; s2 < 2; ++s2) {
        const v4u pw = {cvt2(t.s[8 * s2], t.s[8 * s2 + 1]), cvt2(t.s[8 * s2 + 2], t.s[8 * s2 + 3]), cvt2(t.s[8 * s2 + 4], t.s[8 * s2 + 5]), cvt2(t.s[8 * s2 + 6], t.s[8 * s2 + 7])};
        const bf16x8 pf = __builtin_bit_cast(bf16x8, pw);
        o0 = __builtin_amdgcn_mfma_f32_32x32x16_bf16(frag_tp(VS, 96, krow0 + 16 * s2, 0, lane), pf, o0, 0, 0, 0);
        o1 = __builtin_amdgcn_mfma_f32_32x32x16_bf16(frag_tp(VS, 96, krow0 + 16 * s2, 32, lane), pf, o1, 0, 0, 0);
    }
}
__device__ __forceinline__ void attn_unit(const MixCtx& c, int b, int h, int qb, float lam, float lam_init, LAS unsigned char* lds, int wave, int lane) {
    constexpr float LOG2E = 1.4426950408889634f;
    constexpr int STAGE = 18432 + 24576;
    const int tid = wave * 64 + lane;
    lf32 LUT = (lf32)lds;
    lf32 OB = (lf32)(lds + 1024);
    const int m = wave >> 2, qs = wave & 3, r = lane & 31, hh = lane >> 5;
    const int q0 = qb * 128 + qs * 32, qpos = q0 + r;
    WG_BAR();
    if (tid < 224) { const int d = 191 - tid; LUT[tid] = c.in[I_RELB][T5_BUCKET[d < 0 ? 0 : (d < 127 ? d : 127)] * 4 + h] * LOG2E; }
    bf16x8 qf[2];
    { const bf16* qp = c.PROJ + ((size_t)b * S + qpos) * PJ + O_DQ + h * 64 + m * 32 + 8 * hh; qf[0] = *(const bf16x8*)qp; qf[1] = *(const bf16x8*)(qp + 16); }
    f32x16 o0 = zero16(), o1 = zero16(); float mrun = -1e30f, lrun = 0.f;
    const float c1 = 0.17677669529663687f * LOG2E;
    const int soct = tid & 7, sr0 = tid >> 3;
    const bf16* kvbase = c.PROJ + ((size_t)b * S + sr0) * PJ + h * 64 + 8 * soct;
    v4u kreg[2], vreg[2];
#define ATT_LOAD(kb_) do { _Pragma("unroll") for (int pass = 0; pass < 2; ++pass) { const bf16* row = kvbase + (size_t)((kb_) * 128 + 64 * pass) * PJ; kreg[pass] = *(const v4u*)(row + O_DK); vreg[pass] = *(const v4u*)(row + O_DV); } } while (0)
#define ATT_STORE(buf_) do { LAS unsigned char* sb_ = lds + 1024 + (buf_) * STAGE; _Pragma("unroll") for (int pass = 0; pass < 2; ++pass) { const int key = sr0 + 64 * pass; \
        *(LAS v4u*)((lbf)sb_ + key * 72 + 8 * soct) = kreg[pass]; *(LAS v4u*)((lbf)(sb_ + 18432) + key * 96 + 8 * soct) = vreg[pass]; } } while (0)
    ATT_LOAD(0);
    ATT_STORE(0);
    if (qb > 0) ATT_LOAD(1);
    WG_BAR();
#pragma unroll 1
    for (int kb = 0; kb <= qb; ++kb) {
        lbf KS = (lbf)(lds + 1024 + (kb & 1) * STAGE), VS = (lbf)(lds + 1024 + (kb & 1) * STAGE + 18432);
        const int ntile = (kb < qb) ? 4 : qs + 1;
        int kt = 0;
#pragma unroll 1
        for (; kt + 1 < ntile; kt += 2) {
            const int k0 = kb * 128 + kt * 32;
            AttnTile ta, tb; ta.far = (q0 - k0 >= 144); tb.far = (q0 - (k0 + 32) >= 144);
            attn_qk(ta, KS, kt, m, qf, lane); attn_qk(tb, KS, kt + 1, m, qf, lane);
            const float mt = xhalf_max(fmaxf(attn_tmax(ta, c1, LUT, qpos, k0, hh, k0 == q0), attn_tmax(tb, c1, LUT, qpos, k0 + 32, hh, k0 + 32 == q0)));
            const float mn = fmaxf(mrun, mt);
            if (__any(mn > mrun)) { const float al = __builtin_amdgcn_exp2f(mrun - mn); lrun *= al;
#pragma unroll
                for (int i = 0; i < 16; ++i) { o0[i] *= al; o1[i] *= al; } }
            mrun = mn;
            lrun += attn_probs(ta, c1, LUT, mn) + attn_probs(tb, c1, LUT, mn);
            attn_pv(ta, VS, kt * 32, o0, o1, lane); attn_pv(tb, VS, kt * 32 + 32, o0, o1, lane);
        }
        if (kt < ntile) {
            const int k0 = kb * 128 + kt * 32;
            AttnTile ta; ta.far = (q0 - k0 >= 144);
            attn_qk(ta, KS, kt, m, qf, lane);
            const float mt = xhalf_max(attn_tmax(ta, c1, LUT, qpos, k0, hh, k0 == q0));
            const float mn = fmaxf(mrun, mt);
            if (__any(mn > mrun)) { const float al = __builtin_amdgcn_exp2f(mrun - mn); lrun *= al;
#pragma unroll
                for (int i = 0; i < 16; ++i) { o0[i] *= al; o1[i] *= al; } }
            mrun = mn;
            lrun += attn_probs(ta, c1, LUT, mn);
            attn_pv(ta, VS, kt * 32, o0, o1, lane);
        }
        if (kb < qb) {
            ATT_STORE((kb + 1) & 1);
            if (kb + 1 < qb) ATT_LOAD(kb + 2);
        }
        WG_BAR();
    }
#undef ATT_LOAD
#undef ATT_STORE
    lrun = xhalf_sum(lrun);
    { const float inv = 1.f / lrun; lf32 ob = OB + (size_t)(m * 128 + qs * 32 + r) * 68;
#pragma unroll
      for (int i = 0; i < 16; ++i) { ob[crow(i, hh)] = o0[i] * inv; ob[32 + crow(i, hh)] = o1[i] * inv; } }
    WG_BAR();
    {
        const int q = tid >> 2, part = tid & 3; const float* nw = c.in[I_DNW] + c.L * 64 + 16 * part;
        float o[16]; float ss = 0.f;
#pragma unroll
        for (int k = 0; k < 4; ++k) { const f32x4 x0 = *(const LAS f32x4*)(OB + (size_t)q * 68 + 16 * part + 4 * k), x1 = *(const LAS f32x4*)(OB + (size_t)(128 + q) * 68 + 16 * part + 4 * k);
            const f32x4 d = x0 - x1 * lam; o[4 * k] = d.x; o[4 * k + 1] = d.y; o[4 * k + 2] = d.z; o[4 * k + 3] = d.w; ss += (d.x * d.x + d.y * d.y) + (d.z * d.z + d.w * d.w); }
        ss += shfl_f(ss, lane ^ 1); ss += shfl_f(ss, lane ^ 2);
        const float rs = rsqrtf(ss * (1.f / 64.f) + EPS) * (1.f - lam_init);
        bf16* dst = c.MIX + ((size_t)b * S + qb * 128 + q) * 1024 + 512 + h * 64 + 16 * part;
#pragma unroll
        for (int k = 0; k < 2; ++k) *(v4u*)(dst + 8 * k) = (v4u){cvt2(o[8 * k] * rs * nw[8 * k], o[8 * k + 1] * rs * nw[8 * k + 1]), cvt2(o[8 * k + 2] * rs * nw[8 * k + 2], o[8 * k + 3] * rs * nw[8 * k + 3]),
                                                                 cvt2(o[8 * k + 4] * rs * nw[8 * k + 4], o[8 * k + 5] * rs * nw[8 * k + 5]), cvt2(o[8 * k + 6] * rs * nw[8 * k + 6], o[8 * k + 7] * rs * nw[8 * k + 7])};
    }
}

__device__ __forceinline__ float attn3_tmax(AttnTile& t, lf32 RLb, int qpos, int k0, int hh, bool diag) {
    float mt;
    if (t.far) { mt = t.s[0];
#pragma unroll
        for (int i = 1; i < 16; ++i) mt = fmaxf(mt, t.s[i]);
        return mt; }
    lf32 rb = RLb + (191 - qpos + k0 + 4 * hh);
    float bias[16];
#pragma unroll
    for (int i = 0; i < 16; ++i) bias[i] = rb[(i & 3) + 8 * (i >> 2)];
    mt = -1e30f;
    if (diag) {
#pragma unroll
        for (int i = 0; i < 16; ++i) { const float v = (k0 + crow(i, hh) <= qpos) ? t.s[i] + bias[i] : -1e30f; t.s[i] = v; mt = fmaxf(mt, v); }
    } else {
#pragma unroll
        for (int i = 0; i < 16; ++i) { const float v = t.s[i] + bias[i]; t.s[i] = v; mt = fmaxf(mt, v); }
    }
    return mt;
}
__device__ __forceinline__ float attn3_probs(AttnTile& t) {
    float ps = 0.f;
#pragma unroll
    for (int i = 0; i < 16; ++i) { t.s[i] = __builtin_amdgcn_exp2f(t.s[i]); ps += t.s[i]; }
    return ps;
}
__device__ __forceinline__ void attn3_unit(const MixCtx& c, int b, int h, int qb, float lam, float lam_init, LAS unsigned char* lds, int wave, int lane) {
    constexpr float LOG2E = 1.4426950408889634f, THR = 6.0f;
    constexpr int STAGE = 18432 + 24576;
    const int tid = wave * 64 + lane;
    lf32 LUT = (lf32)lds;
    lf32 OB = (lf32)(lds + 1024);
    const int m = wave >> 2, qs = wave & 3, r = lane & 31, hh = lane >> 5;
    const int q0 = qb * 128 + qs * 32, qpos = q0 + r;
    const float cb = c.in[I_RELB][31 * 4 + h] * LOG2E;
    WG_BAR();
    if (tid < 224) { const int d = 191 - tid; LUT[tid] = c.in[I_RELB][T5_BUCKET[d < 0 ? 0 : (d < 127 ? d : 127)] * 4 + h] * LOG2E - cb; }
    bf16x8 qf[2];
    { const bf16* qp = c.PROJ + ((size_t)b * S + qpos) * PJ + O_DQ + h * 64 + m * 32 + 8 * hh; qf[0] = *(const bf16x8*)qp; qf[1] = *(const bf16x8*)(qp + 16); }
    f32x16 o0 = zero16(), o1 = zero16(), negm; float lrun = 0.f;
#pragma unroll
    for (int i = 0; i < 16; ++i) negm[i] = cb;
    const int soct = tid & 7, sr0 = tid >> 3;
    const bf16* kvbase = c.PROJ + ((size_t)b * S + sr0) * PJ + h * 64 + 8 * soct;
    v4u kreg[2], vreg[2];
#define ATT_LOAD(kb_) do { _Pragma("unroll") for (int pass = 0; pass < 2; ++pass) { const bf16* row = kvbase + (size_t)((kb_) * 128 + 64 * pass) * PJ; kreg[pass] = *(const v4u*)(row + O_DK); vreg[pass] = *(const v4u*)(row + O_DV); } } while (0)
#define ATT_STORE(buf_) do { LAS unsigned char* sb_ = lds + 1024 + (buf_) * STAGE; _Pragma("unroll") for (int pass = 0; pass < 2; ++pass) { const int key = sr0 + 64 * pass; \
        *(LAS v4u*)((lbf)sb_ + key * 72 + 8 * soct) = kreg[pass]; *(LAS v4u*)((lbf)(sb_ + 18432) + key * 96 + 8 * soct) = vreg[pass]; } } while (0)
#define ATT_QK(t_, kt_) do { lbf kp_ = KS + ((kt_) * 32 + r) * 72 + m * 32 + 8 * hh; \
        (t_).s = __builtin_amdgcn_mfma_f32_32x32x16_bf16(*(const LAS bf16x8*)kp_, qf[0], negm, 0, 0, 0); \
        (t_).s = __builtin_amdgcn_mfma_f32_32x32x16_bf16(*(const LAS bf16x8*)(kp_ + 16), qf[1], (t_).s, 0, 0, 0); } while (0)
    ATT_LOAD(0);
    ATT_STORE(0);
    if (qb > 0) ATT_LOAD(1);
    WG_BAR();
#pragma unroll 1
    for (int kb = 0; kb <= qb; ++kb) {
        lbf KS = (lbf)(lds + 1024 + (kb & 1) * STAGE), VS = (lbf)(lds + 1024 + (kb & 1) * STAGE + 18432);
        const int ntile = (kb < qb) ? 4 : qs + 1;
        int kt = 0;
#pragma unroll 1
        for (; kt + 1 < ntile; kt += 2) {
            const int k0 = kb * 128 + kt * 32;
            AttnTile ta, tb; ta.far = (q0 - k0 >= 144); tb.far = (q0 - (k0 + 32) >= 144);
            ATT_QK(ta, kt); ATT_QK(tb, kt + 1);
            const float tm = xhalf_max(fmaxf(attn3_tmax(ta, LUT, qpos, k0, hh, k0 == q0), attn3_tmax(tb, LUT, qpos, k0 + 32, hh, k0 + 32 == q0)));
            if (__any(tm > THR)) { const float d = (tm > THR) ? tm : 0.f, al = __builtin_amdgcn_exp2f(-d); lrun *= al;
#pragma unroll
                for (int i = 0; i < 16; ++i) { o0[i] *= al; o1[i] *= al; negm[i] -= d; ta.s[i] -= d; tb.s[i] -= d; } }
            lrun += attn3_probs(ta) + attn3_probs(tb);
            attn_pv(ta, VS, kt * 32, o0, o1, lane); attn_pv(tb, VS, kt * 32 + 32, o0, o1, lane);
        }
        if (kt < ntile) {
            const int k0 = kb * 128 + kt * 32;
            AttnTile ta; ta.far = (q0 - k0 >= 144);
            ATT_QK(ta, kt);
            const float tm = xhalf_max(attn3_tmax(ta, LUT, qpos, k0, hh, k0 == q0));
            if (__any(tm > THR)) { const float d = (tm > THR) ? tm : 0.f, al = __builtin_amdgcn_exp2f(-d); lrun *= al;
#pragma unroll
                for (int i = 0; i < 16; ++i) { o0[i] *= al; o1[i] *= al; negm[i] -= d; ta.s[i] -= d; } }
            lrun += attn3_probs(ta);
            attn_pv(ta, VS, kt * 32, o0, o1, lane);
        }
        if (kb < qb) {
            ATT_STORE((kb + 1) & 1);
            if (kb + 1 < qb) ATT_LOAD(kb + 2);
        }
        WG_BAR();
    }
#undef ATT_LOAD
#undef ATT_STORE
#undef ATT_QK
    lrun = xhalf_sum(lrun);
    { const float inv = 1.f / lrun; lf32 ob = OB + (size_t)(m * 128 + qs * 32 + r) * 68;
#pragma unroll
      for (int i = 0; i < 16; ++i) { ob[crow(i, hh)] = o0[i] * inv; ob[32 + crow(i, hh)] = o1[i] * inv; } }
    WG_BAR();
    {
        const int q = tid >> 2, part = tid & 3; const float* nw = c.in[I_DNW] + c.L * 64 + 16 * part;
        float o[16]; float ss = 0.f;
#pragma unroll
        for (int k = 0; k < 4; ++k) { const f32x4 x0 = *(const LAS f32x4*)(OB + (size_t)q * 68 + 16 * part + 4 * k), x1 = *(const LAS f32x4*)(OB + (size_t)(128 + q) * 68 + 16 * part + 4 * k);
            const f32x4 d = x0 - x1 * lam; o[4 * k] = d.x; o[4 * k + 1] = d.y; o[4 * k + 2] = d.z; o[4 * k + 3] = d.w; ss += (d.x * d.x + d.y * d.y) + (d.z * d.z + d.w * d.w); }
        ss += shfl_f(ss, lane ^ 1); ss += shfl_f(ss, lane ^ 2);
        const float rs = rsqrtf(ss * (1.f / 64.f) + EPS) * (1.f - lam_init);
        bf16* dst = c.MIX + ((size_t)b * S + qb * 128 + q) * 1024 + 512 + h * 64 + 16 * part;
#pragma unroll
        for (int k = 0; k < 2; ++k) *(v4u*)(dst + 8 * k) = (v4u){cvt2(o[8 * k] * rs * nw[8 * k], o[8 * k + 1] * rs * nw[8 * k + 1]), cvt2(o[8 * k + 2] * rs * nw[8 * k + 2], o[8 * k + 3] * rs * nw[8 * k + 3]),
                                                                 cvt2(o[8 * k + 4] * rs * nw[8 * k + 4], o[8 * k + 5] * rs * nw[8 * k + 5]), cvt2(o[8 * k + 6] * rs * nw[8 * k + 6], o[8 * k + 7] * rs * nw[8 * k + 7])};
    }
}

__device__ __forceinline__ void ml_out2_unit(const MixCtx& c, int up, LAS unsigned char* lds, int wave, int lane) {
    const int half = wave >> 2, li = wave & 3, u = 2 * up + half, h = u & 3, bc = u >> 2, t0 = bc * 128;
    const int ht = (wave & 3) * 64 + lane;
    const int r = lane & 31, hh = lane >> 5, l = 32 * li + r;
    LAS unsigned char* hb = lds + half * 73216;
    lf32 RM = (lf32)hb, U = (lf32)(hb + 512), MT = (lf32)(hb + 1024), WI = (lf32)(hb + 1536), NP = (lf32)(hb + 2048);
    lbf Q = (lbf)(hb + 2560), Kk = (lbf)(hb + 2560 + 18432), VS = (lbf)(hb + 2560 + 2 * 18432), CP = (lbf)(hb + 2560 + 2 * 18432 + 24576);
    lbf OT = Q;
    const unsigned char* ms = c.ws + WS_MISC;
    WG_BAR();
    v4u oraw[4];
#pragma unroll
    for (int k = 0; k < 4; ++k) { const int e = ht + 256 * k; oraw[k] = *(const v4u*)(c.PROJ + (size_t)(t0 + (e >> 3)) * PJ + O_MO + h * 64 + 8 * (e & 7)); }
    {
#pragma unroll
        for (int k = 0; k < 4; ++k) { const int e = ht + 256 * k, s = e >> 3, oct = e & 7; const bf16* row = c.PROJ + (size_t)(t0 + s) * PJ + h * 64 + 8 * oct;
            *(LAS v4u*)(Q + s * 72 + 8 * oct) = *(const v4u*)(row + O_MQ);
            float kv[8]; unpack8(*(const v4u*)(row + O_MK), kv);
#pragma unroll
            for (int q = 0; q < 8; ++q) kv[q] *= 0.125f;
            *(LAS v4u*)(Kk + s * 72 + 8 * oct) = pack8(kv);
            *(LAS v4u*)(VS + s * 96 + 8 * oct) = *(const v4u*)(row + O_MV); }
#pragma unroll
        for (int k = 0; k < 2; ++k) { const int e = ht + 256 * k; *(LAS v4u*)(CP + (e >> 3) * 72 + 8 * (e & 7)) = ((const v4u*)(c.cprev + (size_t)u * 4096))[e]; }
    }
    if (li == 0) {
        const float ib = c.in[I_MIB][c.L * 4 + h], fb = c.in[I_MFB][c.L * 4 + h];
        const float li0 = c.SMALL[(size_t)(t0 + 2 * lane) * 16 + SM_MI + h] + ib, li1 = c.SMALL[(size_t)(t0 + 2 * lane + 1) * 16 + SM_MI + h] + ib;
        float b0 = logsigmoid_fast(c.SMALL[(size_t)(t0 + 2 * lane) * 16 + SM_MF + h] + fb), b1 = logsigmoid_fast(c.SMALL[(size_t)(t0 + 2 * lane + 1) * 16 + SM_MF + h] + fb);
        scan_add128(b0, b1, lane);
        const float u0 = li0 - b0, u1 = li1 - b1; float p0 = u0, p1 = u1; scan_max128(p0, p1, lane);
        const float mp = ((const float*)(ms + MS_MP))[u];
        const float in0 = b0 + mp, in1 = b1 + mp, mt0 = fmaxf(in0, b0 + p0), mt1 = fmaxf(in1, b1 + p1);
        U[2 * lane] = u0; U[2 * lane + 1] = u1; RM[2 * lane] = b0 - mt0; RM[2 * lane + 1] = b1 - mt1; MT[2 * lane] = mt0; MT[2 * lane + 1] = mt1;
        WI[2 * lane] = __expf(in0 - mt0); WI[2 * lane + 1] = __expf(in1 - mt1);
        NP[lane] = ((const float*)(ms + MS_NL))[(size_t)u * 64 + lane];
    }
    WG_BAR();
    const float rml = RM[l], wil = WI[l];
    f32x16 a0 = zero16(), a1 = zero16();
    mma<false, false>(a0, CP, 72, 0, Q, 72, 32 * li, 64, lane);
    mma<false, false>(a1, CP, 72, 32, Q, 72, 32 * li, 64, lane);
#pragma unroll
    for (int i = 0; i < 16; ++i) { a0[i] *= wil; a1[i] *= wil; }
    float den = 0.f;
    {
#pragma unroll
        for (int k = 0; k < 4; ++k) { float qv[8]; unpack8(*(const LAS v4u*)(Q + l * 72 + 32 * hh + 8 * k), qv);
#pragma unroll
            for (int q = 0; q < 8; ++q) den += qv[q] * NP[32 * hh + 8 * k + q]; }
        den *= wil;
    }
#pragma unroll 1
    for (int si = 0; si <= li; ++si) {
        f32x16 st = zero16();
        mma<false, false>(st, Kk, 72, 32 * si, Q, 72, 32 * li, 64, lane);
        float us[16];
#pragma unroll
        for (int i = 0; i < 16; ++i) us[i] = U[32 * si + crow(i, hh)];
#pragma unroll
        for (int i = 0; i < 16; ++i) { const int s2 = 32 * si + crow(i, hh); const float w = st[i] * __expf(fminf(rml + us[i], 0.f)); st[i] = (si < li || s2 <= l) ? w : 0.f; den += st[i]; }
#pragma unroll
        for (int s2 = 0; s2 < 2; ++s2) {
            const v4u pw = {cvt2(st[8 * s2], st[8 * s2 + 1]), cvt2(st[8 * s2 + 2], st[8 * s2 + 3]), cvt2(st[8 * s2 + 4], st[8 * s2 + 5]), cvt2(st[8 * s2 + 6], st[8 * s2 + 7])};
            const bf16x8 pf = __builtin_bit_cast(bf16x8, pw);
            a0 = __builtin_amdgcn_mfma_f32_32x32x16_bf16(frag_tp(VS, 96, 32 * si + 16 * s2, 0, lane), pf, a0, 0, 0, 0);
            a1 = __builtin_amdgcn_mfma_f32_32x32x16_bf16(frag_tp(VS, 96, 32 * si + 16 * s2, 32, lane), pf, a1, 0, 0, 0);
        }
    }
    den = xhalf_sum(den);
    const float inv = 1.f / fmaxf(fabsf(den), __expf(-MT[l]));
    float ss = 0.f;
#pragma unroll
    for (int i = 0; i < 16; ++i) { a0[i] *= inv; a1[i] *= inv; ss += a0[i] * a0[i] + a1[i] * a1[i]; }
    ss = xhalf_sum(ss);
    const float rs = rsqrtf(ss * (1.f / 64.f) + EPS);
    WG_BAR();
    {
        const float* nw = c.in[I_MNW] + c.L * 256 + h * 64;
        lbf orow = OT + l * 72 + 4 * hh;
#pragma unroll
        for (int g = 0; g < 4; ++g) { const f32x4 w0 = *(const f32x4*)(nw + 8 * g + 4 * hh), w1 = *(const f32x4*)(nw + 32 + 8 * g + 4 * hh);
            *(LAS u32x2m*)(orow + 8 * g) = (u32x2m){cvt2(a0[4 * g] * rs * w0.x, a0[4 * g + 1] * rs * w0.y), cvt2(a0[4 * g + 2] * rs * w0.z, a0[4 * g + 3] * rs * w0.w)};
            *(LAS u32x2m*)(orow + 32 + 8 * g) = (u32x2m){cvt2(a1[4 * g] * rs * w1.x, a1[4 * g + 1] * rs * w1.y), cvt2(a1[4 * g + 2] * rs * w1.z, a1[4 * g + 3] * rs * w1.w)}; }
    }
    WG_BAR();
#pragma unroll
    for (int k = 0; k < 4; ++k) { const int e = ht + 256 * k, row = e >> 3, piece = e & 7;
        float hv[8], ov[8]; unpack8(*(const LAS v4u*)(OT + row * 72 + 8 * piece), hv); unpack8(oraw[k], ov);
#pragma unroll
        for (int q = 0; q < 8; ++q) hv[q] *= __builtin_amdgcn_rcpf(1.0f + __expf(-ov[q]));
        *(v4u*)(c.MIX + (size_t)(t0 + row) * 1024 + 768 + h * 64 + 8 * piece) = pack8(hv); }
}
}
constexpr int CW_BAR = 4096;
constexpr int N_BAR_REGIONS = 4;
static_assert((CW_BAR + N_BAR_REGIONS * XCD_BAR_WORDS) * 4 <= (int)CTL_ZERO_BYTES, "CTL words inside the memset region");
constexpr int RING_OFF = 0, RING_BYTES = 131072, PHASE_BYTES = 147456;
constexpr int LDSCTL_OFF = PHASE_BYTES, MISC_OFF = LDSCTL_OFF + 320;
constexpr int LDS_BYTES = PHASE_BYTES + 1024;
static_assert(MISC_OFF + 128 <= LDS_BYTES, "LDS map");
#define LDS_WAIT() asm volatile("s_waitcnt lgkmcnt(0)" ::: "memory")

struct Frame {
    LAS unsigned char* lds;
    volatile LAS unsigned* MISC;
    unsigned* ctl;
    int wave, G;
};
#define LANE() lane_id_asm()

__device__ __forceinline__ unsigned pk2(float lo, float hi) { return (unsigned)f2bf(lo) | ((unsigned)f2bf(hi) << 16); }
template <class RM>
__device__ __forceinline__ void transpose_item(const float* W, int K, int N, bf16* WT, RM rowmap, const float* kscale, LAS float* scr, int item, int lane) {
    const int nblk = (N + 31) / 32, kb = item / nblk, nb = item % nblk, k0 = 64 * kb, n0 = 32 * nb;
    const bool nok = (n0 + (lane & 31)) < N;
    float wv_[32];
    const int ncol = nok ? n0 + (lane & 31) : N - 1;
#pragma unroll
    for (int i = 0; i < 32; ++i) { const int kk = 2 * i + (lane >> 5); wv_[i] = W[(size_t)(k0 + kk) * N + ncol]; }
#pragma unroll
    for (int i = 0; i < 32; ++i) { const int kk = 2 * i + (lane >> 5); float v = wv_[i]; if (kscale) v *= kscale[k0 + kk]; scr[kk * 33 + (lane & 31)] = v; }
    LDS_WAIT(); asm volatile("" ::: "memory");
    const int c = lane & 7;
#pragma unroll
    for (int j = 0; j < 4; ++j) { const int n = (lane >> 3) + 8 * j; const LAS float* s = scr + (8 * c) * 33 + n;
        v4u o; o.x = pk2(s[0 * 33], s[1 * 33]); o.y = pk2(s[2 * 33], s[3 * 33]); o.z = pk2(s[4 * 33], s[5 * 33]); o.w = pk2(s[6 * 33], s[7 * 33]);
        if (n0 + n < N) *(v4u*)(WT + (size_t)rowmap(n0 + n) * K + k0 + 8 * c) = o; }
    LDS_WAIT(); asm volatile("" ::: "memory");
}
__device__ __forceinline__ int rowmap_win(int c) { return c < 1536 ? c : (c < 1544 ? 3328 + (c - 1536) : (c < 3336 ? c - 8 : 3328 + 8 + (c - 3336))); }

__device__ __forceinline__ void p0_prologue(Frame& F, const Args& a) {
    unsigned char* ws = a.ws;
    LAS float* scr = (LAS float*)(F.lds + RING_OFF + F.wave * 16384);
    const int lane = LANE(), tid = F.wave * 64 + lane;
    const int gw = blockIdx.x * NWAVES + F.wave, NGW = F.G * NWAVES;
    constexpr int I_IN = 16 * 105, I_SQ = 16 * 32, I_GU = 16 * 88, I_DN = 44 * 32, I_PPJ = 4 * 32;
    constexpr int PER_LAYER = I_IN + I_SQ + 2 * I_GU + I_DN + I_SQ + I_PPJ;
    for (int it = gw; it < DEPTH * PER_LAYER; it += NGW) {
        const int L = it / PER_LAYER; int r = it % PER_LAYER;
        unsigned char* wl = ws + WS_W + (size_t)L * W_LAYER;
        if (r < I_IN) { transpose_item(a.in[I_WIN] + (size_t)L * D * INC, D, INC, (bf16*)(wl + W_IN), [](int c) { return rowmap_win(c); }, a.in[I_N1W] + L * D, scr, r, lane); continue; } r -= I_IN;
        if (r < I_SQ) { transpose_item(a.in[I_WOUT] + (size_t)L * D * D, D, D, (bf16*)(wl + W_OUT), [](int c) { return c; }, nullptr, scr, r, lane); continue; } r -= I_SQ;
        if (r < I_GU) { transpose_item(a.in[I_WG] + (size_t)L * D * FF, D, FF, (bf16*)(wl + W_GU), [](int c) { return 256 * (c >> 7) + (c & 127); }, a.in[I_N2W] + L * D, scr, r, lane); continue; } r -= I_GU;
        if (r < I_GU) { transpose_item(a.in[I_WU] + (size_t)L * D * FF, D, FF, (bf16*)(wl + W_GU), [](int c) { return 256 * (c >> 7) + 128 + (c & 127); }, a.in[I_N2W] + L * D, scr, r, lane); continue; } r -= I_GU;
        if (r < I_DN) { transpose_item(a.in[I_WD] + (size_t)L * FF * D, FF, D, (bf16*)(wl + W_DN), [](int c) { return c; }, nullptr, scr, r, lane); continue; } r -= I_DN;
        if (r < I_SQ) { transpose_item(a.in[I_PGW] + (size_t)L * D * D, D, D, (bf16*)(wl + W_PG), [](int c) { return c; }, nullptr, scr, r, lane); continue; } r -= I_SQ;
        transpose_item(a.in[I_PPW] + (size_t)L * PLE * D, PLE, D, (bf16*)(wl + W_PP), [](int c) { return c; }, nullptr, scr, r, lane);
    }
    {
        const int gt = blockIdx.x * NT + tid, ngt = F.G * NT; constexpr int PER = (NPROJ - INC) * D / 8;
        for (int e = gt; e < DEPTH * PER; e += ngt) { const int L = e / PER, r = e % PER;
            *(v4u*)((bf16*)(ws + WS_W + (size_t)L * W_LAYER + W_IN) + (size_t)INC * D + (size_t)r * 8) = (v4u){0u, 0u, 0u, 0u}; }
    }
    {
        const float* x = a.in[I_X]; bf16* hb2 = (bf16*)(ws + WS_HB2); float* ssqp = (float*)(ws + WS_SSQP);
        for (int m = gw; m < M; m += 2 * NGW) {
            const int m2 = (m + NGW < M) ? m + NGW : m;
            const f32x4* xa = (const f32x4*)(x + (size_t)m * D) + lane; const f32x4* xb = (const f32x4*)(x + (size_t)m2 * D) + lane;
            f32x4 va[4], vb[4];
#pragma unroll
            for (int j = 0; j < 4; ++j) { va[j] = xa[64 * j]; vb[j] = xb[64 * j]; }
            unsigned long long* oa = (unsigned long long*)(hb2 + (size_t)m * D) + lane; unsigned long long* ob = (unsigned long long*)(hb2 + (size_t)m2 * D) + lane; float sa = 0.f, sb = 0.f;
#pragma unroll
            for (int j = 0; j < 4; ++j) { sa += (va[j].x * va[j].x + va[j].y * va[j].y) + (va[j].z * va[j].z + va[j].w * va[j].w); sb += (vb[j].x * vb[j].x + vb[j].y * vb[j].y) + (vb[j].z * vb[j].z + vb[j].w * vb[j].w);
                oa[64 * j] = (unsigned long long)pk2(va[j].x, va[j].y) | ((unsigned long long)pk2(va[j].z, va[j].w) << 32); ob[64 * j] = (unsigned long long)pk2(vb[j].x, vb[j].y) | ((unsigned long long)pk2(vb[j].z, vb[j].w) << 32); }
            sa = wave_sum_l(sa, lane); sb = wave_sum_l(sb, lane);
            if (lane < 16) { ssqp[(size_t)m * 16 + lane] = (lane == 0) ? sa : 0.f; ssqp[(size_t)m2 * 16 + lane] = (lane == 0) ? sb : 0.f; }
        }
    }
    {
        const float* p = a.in[I_P]; bf16* pb = (bf16*)(ws + WS_PB);
        const size_t gt = (size_t)blockIdx.x * NT + tid, ngt = (size_t)F.G * NT, n8 = (size_t)DEPTH * M * PLE / 8;
        for (size_t e = gt; e < n8; e += 4 * ngt) {
            f32x4 v0[4], v1[4];
#pragma unroll
            for (int k = 0; k < 4; ++k) { const size_t ek = (e + k * ngt < n8) ? e + k * ngt : e; v0[k] = *(const f32x4*)(p + ek * 8); v1[k] = *(const f32x4*)(p + ek * 8 + 4); }
#pragma unroll
            for (int k = 0; k < 4; ++k) if (e + k * ngt < n8) *(v4u*)(pb + (e + k * ngt) * 8) = (v4u){pk2(v0[k].x, v0[k].y), pk2(v0[k].z, v0[k].w), pk2(v1[k].x, v1[k].y), pk2(v1[k].z, v1[k].w)};
        }
    }
}

constexpr int NTN = 256;
template <int PH> __global__ void __launch_bounds__(NTN, 1) naive_mix(Args a, int L) {
    extern __shared__ __attribute__((aligned(16))) unsigned char lds_raw[];
    float* ldsf = (float*)lds_raw;
    const int tid = threadIdx.x, lane = tid & 63, wave = tid >> 6;
    const int gtid = blockIdx.x * NTN + tid, gthreads = gridDim.x * NTN;
    const int gw = blockIdx.x * (NTN / 64) + wave, ngw = gridDim.x * (NTN / 64);
    unsigned char* ws = a.ws;
    const bf16* PROJ = (const bf16*)(ws + WS_PROJ); const float* SMALL = (const float*)(ws + WS_SMALL);
    bf16* XC = (bf16*)(ws + WS_XC); bf16* MIX = (bf16*)(ws + WS_MIX);
    if constexpr (PH == 2) {
        const float* cw = a.in[I_CONVW] + L * 4 * 1024; const float* cb = a.in[I_CONVB] + L * 1024;
        for (size_t e = gtid; e < (size_t)M * 1024; e += gthreads) {
            const int ch = (int)(e & 1023), t = (int)(e >> 10), s = t & (S - 1);
            float acc = cb[ch];
#pragma unroll
            for (int k = 0; k < 4; ++k) { const int ss = s - 3 + k; if (ss >= 0) acc += cw[k * 1024 + ch] * bf2f(PROJ[(size_t)(t - 3 + k) * PJ + O_XBC + ch]); }
            XC[e] = f2bf(siluf_(acc));
        }
    }
    if constexpr (PH == 3) {
        for (int u = gw; u < NB * 8; u += ngw) {
            const int b = u >> 3, hd = u & 7, g = hd >> 2;
            const float dtb = a.in[I_DTB][L * 8 + hd], A = -expf(a.in[I_ALOG][L * 8 + hd]), Dsk = a.in[I_SSDD][L * 8 + hd];
            float st[128];
#pragma unroll
            for (int n = 0; n < 128; ++n) st[n] = 0.f;
            for (int s = 0; s < S; ++s) {
                const size_t t = (size_t)b * S + s;
                const float dt = softplusf_(SMALL[t * 16 + SM_DT + hd] + dtb), dA = expf(dt * A);
                const float x = bf2f(XC[t * 1024 + hd * 64 + lane]), xdt = x * dt;
                const v4u* Bp = (const v4u*)(XC + t * 1024 + 512 + g * 128); const v4u* Cp = (const v4u*)(XC + t * 1024 + 768 + g * 128);
                float y = 0.f;
#pragma unroll
                for (int n8 = 0; n8 < 16; ++n8) { const v4u bw = Bp[n8], cw = Cp[n8];
#pragma unroll
                    for (int j = 0; j < 4; ++j) { const unsigned bu = bw[j], cu = cw[j]; const int n = 8 * n8 + 2 * j;
                        st[n] = st[n] * dA + __uint_as_float(bu << 16) * xdt; y += __uint_as_float(cu << 16) * st[n];
                        st[n + 1] = st[n + 1] * dA + __uint_as_float(bu & 0xffff0000u) * xdt; y += __uint_as_float(cu & 0xffff0000u) * st[n + 1]; } }
                MIX[t * 1024 + hd * 64 + lane] = f2bf(y + x * Dsk);
            }
        }
    }
    if constexpr (PH == 4) {
        const float* nw = a.in[I_SSDNW] + L * 512;
        for (int m = gw; m < M; m += ngw) {
            float gv[8]; float s = 0.f;
#pragma unroll
            for (int j = 0; j < 8; ++j) { const int c = lane * 8 + j; const float z = bf2f(PROJ[(size_t)m * PJ + O_Z + c]); gv[j] = bf2f(MIX[(size_t)m * 1024 + c]) * siluf_(z); s += gv[j] * gv[j]; }
            const float r = rsqrtf(wave_sum(s) * (1.f / 512.f) + EPS);
#pragma unroll
            for (int j = 0; j < 8; ++j) { const int c = lane * 8 + j; MIX[(size_t)m * 1024 + c] = f2bf(gv[j] * r * nw[c]); }
        }
    }
    if constexpr (PH == 5) {
        float* lut = ldsf;
        const float lam_init = 0.8f - 0.6f * expf(-0.3f * (float)L);
        float d1 = 0.f, d2 = 0.f;
        for (int i = 0; i < 32; ++i) { d1 += a.in[I_LQ1][L * 32 + i] * a.in[I_LK1][L * 32 + i]; d2 += a.in[I_LQ2][L * 32 + i] * a.in[I_LK2][L * 32 + i]; }
        const float lam = expf(d1) - expf(d2) + lam_init;
        const float* dnw = a.in[I_DNW] + L * 64;
        for (int vb = blockIdx.x; vb < M * 4 / NTN; vb += gridDim.x) {
            const int gid = vb * NTN + tid, q = gid & (S - 1), h = (gid >> 11) & 3, b = gid >> 13;
            __syncthreads();
            if (tid < 128) lut[tid] = a.in[I_RELB][T5_BUCKET[tid] * 4 + h];
            __syncthreads();
            const size_t t = (size_t)b * S + q;
            float q0[32], q1[32];
            const float sc = 0.17677669529663687f;
#pragma unroll
            for (int d = 0; d < 32; ++d) { q0[d] = bf2f(PROJ[t * PJ + O_DQ + h * 64 + d]) * sc; q1[d] = bf2f(PROJ[t * PJ + O_DQ + h * 64 + 32 + d]) * sc; }
            float m0 = -1e30f, l0 = 0.f, m1 = -1e30f, l1 = 0.f;
            const int kend = q | 63;
            for (int k = 0; k <= kend; ++k) {
                const bf16* kp = PROJ + ((size_t)b * S + k) * PJ + O_DK + h * 64;
                float s0 = 0.f, s1 = 0.f;
#pragma unroll
                for (int d = 0; d < 32; ++d) { s0 += q0[d] * bf2f(kp[d]); s1 += q1[d] * bf2f(kp[32 + d]); }
                if (k <= q) {
                    const int dist = q - k; const float bias = lut[dist < 127 ? dist : 127];
                    s0 += bias; s1 += bias;
                    if (s0 > m0) { l0 = l0 * __expf(m0 - s0) + 1.f; m0 = s0; } else l0 += __expf(s0 - m0);
                    if (s1 > m1) { l1 = l1 * __expf(m1 - s1) + 1.f; m1 = s1; } else l1 += __expf(s1 - m1);
                }
            }
            float o[64];
#pragma unroll
            for (int e = 0; e < 64; ++e) o[e] = 0.f;
            const float il0 = 1.f / l0, il1 = lam / l1;
            for (int k = 0; k <= kend; ++k) {
                const bf16* kp = PROJ + ((size_t)b * S + k) * PJ + O_DK + h * 64;
                const bf16* vp = PROJ + ((size_t)b * S + k) * PJ + O_DV + h * 64;
                float s0 = 0.f, s1 = 0.f;
#pragma unroll
                for (int d = 0; d < 32; ++d) { s0 += q0[d] * bf2f(kp[d]); s1 += q1[d] * bf2f(kp[32 + d]); }
                float w = 0.f;
                if (k <= q) { const int dist = q - k; const float bias = lut[dist < 127 ? dist : 127]; w = __expf(s0 + bias - m0) * il0 - __expf(s1 + bias - m1) * il1; }
#pragma unroll
                for (int e = 0; e < 64; ++e) o[e] += w * bf2f(vp[e]);
            }
            float ss = 0.f;
#pragma unroll
            for (int e = 0; e < 64; ++e) ss += o[e] * o[e];
            const float r = rsqrtf(ss * (1.f / 64.f) + EPS) * (1.f - lam_init);
#pragma unroll
            for (int e = 0; e < 64; ++e) MIX[t * 1024 + 512 + h * 64 + e] = f2bf(o[e] * r * dnw[e]);
        }
    }
    if constexpr (PH == 6) {
        for (int u = gw; u < NB * 4; u += ngw) {
            const int b = u >> 2, h = u & 3;
            const float ib = a.in[I_MIB][L * 4 + h], fb = a.in[I_MFB][L * 4 + h], nwe = a.in[I_MNW][L * 256 + h * 64 + lane];
            float C[64], nv[64];
#pragma unroll
            for (int d = 0; d < 64; ++d) { C[d] = 0.f; nv[d] = 0.f; }
            float mprev = 0.f;
            for (int s = 0; s < S; ++s) {
                const size_t t = (size_t)b * S + s; const bf16* row = PROJ + t * PJ;
                const float logi = SMALL[t * 16 + SM_MI + h] + ib, logf_ = logsigmoidf_(SMALL[t * 16 + SM_MF + h] + fb);
                const float mnew = fmaxf(logf_ + mprev, logi), fa = expf(logf_ + mprev - mnew), ia = expf(logi - mnew);
                const float ve = bf2f(row[O_MV + h * 64 + lane]) * ia;
                float num = 0.f, den = 0.f;
#pragma unroll
                for (int d = 0; d < 64; ++d) {
                    const float kd = bf2f(row[O_MK + h * 64 + d]) * 0.125f, qd = bf2f(row[O_MQ + h * 64 + d]);
                    C[d] = C[d] * fa + ve * kd; nv[d] = nv[d] * fa + ia * kd; num += C[d] * qd; den += nv[d] * qd;
                }
                const float hv = num / fmaxf(fabsf(den), expf(-mnew));
                const float r = rsqrtf(wave_sum(hv * hv) * (1.f / 64.f) + EPS);
                MIX[t * 1024 + 768 + h * 64 + lane] = f2bf(sigmoidf_(bf2f(row[O_MO + h * 64 + lane])) * hv * r * nwe);
                mprev = mnew;
            }
        }
    }
}

__device__ __forceinline__ void fill_rstd_table(const pg8::StaticOrder& So, const float* ssqp, LAS float* rtab, int wave, int lane) {
    const int tid = wave * 64 + lane;
    for (int i = tid >> 8; ; i += 2) { pg8::Unit u; if (!So.next(i, u)) break;
        const f32x4* p = (const f32x4*)(ssqp + (size_t)(u.pm * 256 + (tid & 255)) * 16);
        const f32x4 a = p[0], b = p[1], c = p[2], d = p[3];
        const float s = (((a.x + a.y) + (a.z + a.w)) + ((b.x + b.y) + (b.z + b.w))) + (((c.x + c.y) + (c.z + c.w)) + ((d.x + d.y) + (d.z + d.w)));
        rtab[i * 256 + (tid & 255)] = rsqrtf(s * (1.0f / 1024.0f) + EPS); }
    __syncthreads();
}

#ifndef SMALL_WGM
#define SMALL_WGM 4
#endif
constexpr int PH_FINAL = 1 + 8 * DEPTH, PH_END = PH_FINAL + 1;
__global__ void __launch_bounds__(NT, 2) mk_fwd(Args a) {
    extern __shared__ __attribute__((aligned(16))) unsigned char lds[];
    Frame F;
    F.lds = (LAS unsigned char*)lds;
    F.MISC = (volatile LAS unsigned*)(F.lds + MISC_OFF);
    F.wave = __builtin_amdgcn_readfirstlane(threadIdx.x >> 6);
    F.G = gridDim.x;
    unsigned char* ws = a.ws;
    F.ctl = (unsigned*)(ws + WS_CTL);
    for (int u = F.wave * 64 + LANE(); u < (LDS_BYTES - LDSCTL_OFF) / 4; u += NT) ((LAS unsigned*)(F.lds + LDSCTL_OFF))[u] = 0u;
    __syncthreads();
    XcdBarrier bar = xcd_barrier_post(F.ctl + CW_BAR + a.li * XCD_BAR_WORDS, F.MISC + 8, F.wave);
    const int lo = a.ph_lo, hi = a.ph_hi;
#define IN(k) (lo <= (k) && (k) < hi)
#define SEAM(k) do { if (IN(k) && IN((k) + 1)) xcd_barrier(bar); } while (0)
#ifndef DUP_MASK
#define DUP_MASK 0
#endif
#define DUP(kk) (((DUP_MASK) >> (kk)) & 1)
#ifndef DUP_PARTS
#define DUP_PARTS 7
#endif
    float* H = a.out;
    float* SSQP = (float*)(ws + WS_SSQP); float* SMALL = (float*)(ws + WS_SMALL);
    pg8::bf16_t* HB = (pg8::bf16_t*)(ws + WS_HB); pg8::bf16_t* HB2 = (pg8::bf16_t*)(ws + WS_HB2);
    pg8::bf16_t* PROJ = (pg8::bf16_t*)(ws + WS_PROJ); pg8::bf16_t* HID = (pg8::bf16_t*)(ws + WS_HID);
    pg8::bf16_t* MIX = (pg8::bf16_t*)(ws + WS_MIX); pg8::bf16_t* PP = (pg8::bf16_t*)(ws + WS_PP);

    if (IN(0)) { p0_prologue(F, a); }
#if DUP(8)
    if (IN(0)) { xcd_barrier(bar); p0_prologue(F, a); }
#endif
    SEAM(0);

    for (int L = 0; L < DEPTH; ++L) {
        const int P0 = 1 + 8 * L;
        const unsigned char* wl = ws + WS_W + (size_t)L * W_LAYER;
#define BODY_G1 \
            pg8::Gemm g{HB2, (const pg8::bf16_t*)(wl + W_IN), M, NPROJ, D}; pg8::StaticOrder So; So.init(M, NPROJ, F.G, (int)blockIdx.x); \
            fill_rstd_table(So, SSQP, (LAS float*)(F.lds + RING_BYTES), F.wave, LANE()); \
            pg8::EpiProj E{PROJ, SMALL, (const LAS float*)(F.lds + RING_BYTES)}; \
            pg8::gemm_phase<pg8::EpiProj, pg8::StaticOrder, true, true>(F.wave, F.lds + RING_OFF, g, So, E); \

        if (IN(P0 + 0)) { BODY_G1 }
#if DUP(0)
        if (IN(P0 + 0)) { xcd_barrier(bar); BODY_G1 }
#endif
        SEAM(P0 + 0);
        const mx::MixCtx mc{(const bf16*)PROJ, SMALL, (bf16*)MIX, ws, a.in, L, H, H + (size_t)16 * 1024 * 1024, (bf16*)(H + (size_t)20 * 1024 * 1024), (bf16*)(H + (size_t)28 * 1024 * 1024)};
#define BODY_A \
            const float lam_init = __int_as_float(__builtin_amdgcn_readfirstlane(__float_as_int(0.8f - 0.6f * __expf(-0.3f * (float)L)))); \
            float d1 = 0.f, d2 = 0.f; \
            for (int i = 0; i < 32; ++i) { d1 += a.in[I_LQ1][L * 32 + i] * a.in[I_LK1][L * 32 + i]; d2 += a.in[I_LQ2][L * 32 + i] * a.in[I_LK2][L * 32 + i]; } \
            const float lam_v = __expf(d1) - __expf(d2) + lam_init; \
            const float lam = __int_as_float(__builtin_amdgcn_readfirstlane(__float_as_int(lam_v))); \
            for (int u = blockIdx.x; u < 2048; u += F.G) { \
                const int lane = LANE(); \
                if (u < 512) { if (PARTS & 1) {   \
                    const int x_ = u & 7, t_ = (u >> 3) & 63, bh = (F.G == 256) ? x_ + 8 * (t_ >> 3) : u >> 3, j = (F.G == 256) ? (t_ & 7) : (u & 7); \
                    mx::attn3_unit(mc, bh >> 2, bh & 3, 15 - j, lam, lam_init, F.lds, F.wave, lane); mx::attn3_unit(mc, bh >> 2, bh & 3, j, lam, lam_init, F.lds, F.wave, lane); } } \
                else if (u < 1024) { if (PARTS & 2) mx::ssd_states_unit(mc, u - 512, F.lds, F.wave, lane); } \
                else { if (PARTS & 4) mx::ml_summary_unit(mc, u - 1024, F.lds, F.wave, lane); } \
            } \

#define PARTS 7
        if (IN(P0 + 1)) { BODY_A }
#undef PARTS
#define PARTS DUP_PARTS
#if DUP(1)
        if (IN(P0 + 1)) { xcd_barrier(bar); BODY_A }
#endif
#undef PARTS
        SEAM(P0 + 1);
        if (IN(P0 + 2)) mx::scan_phase(mc, F.G, F.wave, LANE());
#if DUP(2)
#define PARTS 6
        if (IN(P0 + 2)) { xcd_barrier(bar); { BODY_A } xcd_barrier(bar); mx::scan_phase(mc, F.G, F.wave, LANE()); }
#undef PARTS
#endif
        SEAM(P0 + 2);
#define BODY_C \
            for (int u = blockIdx.x; u < 768; u += F.G) { \
                const int lane = LANE(); \
                if (u < 256) { if (PARTS & 1) mx::ssd_out_unit(mc, u, F.lds, F.wave, lane); } \
                else { if (PARTS & 2) mx::ml_out2_unit(mc, u - 256, F.lds, F.wave, lane); } \
            } \

#ifdef SSD_PROBE_VAR
        if (IN(P0 + 3)) { for (int u = blockIdx.x; u < 256; u += F.G) mx::ssd_out_unit<SSD_PROBE_VAR>(mc, u, F.lds, F.wave, LANE()); xcd_barrier(bar); }
#endif
#define PARTS 7
        if (IN(P0 + 3)) { BODY_C }
#undef PARTS
#define PARTS DUP_PARTS
#if DUP(3)
        if (IN(P0 + 3)) { xcd_barrier(bar); BODY_C }
#endif
#undef PARTS
        SEAM(P0 + 3);
        if (IN(P0 + 4)) {
            pg8::Gemm g{MIX, (const pg8::bf16_t*)(wl + W_OUT), M, D, D}; pg8::StaticOrder So; So.init(M, D, F.G, (int)blockIdx.x, SMALL_WGM);
            if (L == 0) { pg8::EpiRes<0, true> E{a.in[I_X], HB, SSQP, nullptr};
                pg8::gemm_phase<pg8::EpiRes<0, true>, pg8::StaticOrder, true, true>(F.wave, F.lds + RING_OFF, g, So, E); }
            else { pg8::EpiRes<0, false> E{HB2, HB, SSQP, nullptr};
                pg8::gemm_phase<pg8::EpiRes<0, false>, pg8::StaticOrder, true, true>(F.wave, F.lds + RING_OFF, g, So, E); }
        }
        SEAM(P0 + 4);
#define BODY_G3 \
            pg8::Gemm g{HB, (const pg8::bf16_t*)(wl + W_GU), M, 2 * FF, D}; pg8::StaticOrder So; So.init(M, 2 * FF, F.G, (int)blockIdx.x); \
            fill_rstd_table(So, SSQP, (LAS float*)(F.lds + RING_BYTES), F.wave, LANE()); \
            pg8::EpiGateUp E{HID, (const LAS float*)(F.lds + RING_BYTES)}; \
            pg8::gemm_phase<pg8::EpiGateUp, pg8::StaticOrder, true, true>(F.wave, F.lds + RING_OFF, g, So, E); \

        if (IN(P0 + 5)) { BODY_G3 }
#if DUP(5)
        if (IN(P0 + 5)) { xcd_barrier(bar); BODY_G3 }
#endif
        SEAM(P0 + 5);
        if (IN(P0 + 6)) {
            { pg8::Gemm g{HID, (const pg8::bf16_t*)(wl + W_DN), M, D, FF}; pg8::StaticOrder So; So.init(M, D, F.G, (int)blockIdx.x, SMALL_WGM);
              pg8::EpiRes<1, false> E{HB, HB, nullptr, nullptr};
              pg8::gemm_phase<pg8::EpiRes<1, false>, pg8::StaticOrder, true, true>(F.wave, F.lds + RING_OFF, g, So, E); }
            { pg8::Gemm g{(const pg8::bf16_t*)(ws + WS_PB) + (size_t)L * M * PLE, (const pg8::bf16_t*)(wl + W_PP), M, D, PLE}; pg8::StaticOrder So; So.init(M, D, F.G, (int)blockIdx.x, SMALL_WGM);
              pg8::EpiBf16<0> E{PP, D, nullptr, 0, 0, 1.f};
              pg8::gemm_phase<pg8::EpiBf16<0>, pg8::StaticOrder, true, true>(F.wave, F.lds + RING_OFF, g, So, E); }
        }
        SEAM(P0 + 6);
        if (IN(P0 + 7)) {
            pg8::Gemm g{HB, (const pg8::bf16_t*)(wl + W_PG), M, D, D}; pg8::StaticOrder So; So.init(M, D, F.G, (int)blockIdx.x, SMALL_WGM);
            pg8::EpiRes<2, false> E{HB, HB2, SSQP, PP};
            pg8::gemm_phase<pg8::EpiRes<2, false>, pg8::StaticOrder, true, true>(F.wave, F.lds + RING_OFF, g, So, E);
        }
        SEAM(P0 + 7);
    }
    if (IN(PH_FINAL)) {
        const float* fw = a.in[I_FNW]; const int gw = blockIdx.x * NWAVES + F.wave, NGW = F.G * NWAVES, lane = LANE();
        f32x4 wv[4];
#pragma unroll
        for (int j = 0; j < 4; ++j) wv[j] = ((const f32x4*)fw)[2 * lane + 128 * (j >> 1) + (j & 1)];
        for (int m0 = gw; m0 < M; m0 += 2 * NGW) {
            v4u w0[2], w1[2]; float sp_[2];
#pragma unroll
            for (int k = 0; k < 2; ++k) { const int m = (m0 + k * NGW < M) ? m0 + k * NGW : m0; const v4u* src = (const v4u*)(HB2 + (size_t)m * D) + lane; w0[k] = src[0]; w1[k] = src[64]; sp_[k] = (lane < 16) ? SSQP[(size_t)m * 16 + lane] : 0.f; }
#pragma unroll
            for (int k = 0; k < 2; ++k) { const int m = (m0 + k * NGW < M) ? m0 + k * NGW : m0; f32x4* dst = (f32x4*)(H + (size_t)m * D) + 2 * lane; float s = sp_[k];
                s += shfl_f(s, lane ^ 1); s += shfl_f(s, lane ^ 2); s += shfl_f(s, lane ^ 4); s += shfl_f(s, lane ^ 8);
                const float rs = rsqrtf(shfl_f(s, 0) * (1.f / D) + EPS);
                float v0[8], v1[8]; mx::unpack8(w0[k], v0); mx::unpack8(w1[k], v1);
                dst[0] = (f32x4){v0[0], v0[1], v0[2], v0[3]} * rs * wv[0]; dst[1] = (f32x4){v0[4], v0[5], v0[6], v0[7]} * rs * wv[1];
                dst[128] = (f32x4){v1[0], v1[1], v1[2], v1[3]} * rs * wv[2]; dst[129] = (f32x4){v1[4], v1[5], v1[6], v1[7]} * rs * wv[3]; }
        }
    }
#undef IN
#undef SEAM
}

extern "C" void kernel_launch(void* const* d_in, const int* in_sizes, int n_in, void* d_out, int out_size, void* d_ws, size_t ws_size, hipStream_t stream) {
    static int grid = 0;
    if (grid == 0) {
        if (n_in != 27 || in_sizes[0] != M * D || out_size != M * D || ws_size < WS_END) { fprintf(stderr, "kernel_launch: unexpected shapes (n_in %d, ws %zu)\n", n_in, ws_size); grid = -1; return; }
        int dev = 0, cus = 0, per_cu = 0;
        if (hipGetDevice(&dev) != hipSuccess || hipDeviceGetAttribute(&cus, hipDeviceAttributeMultiprocessorCount, dev) != hipSuccess) { grid = -1; return; }
        if (hipFuncSetAttribute((const void*)mk_fwd, hipFuncAttributeMaxDynamicSharedMemorySize, LDS_BYTES) != hipSuccess) { fprintf(stderr, "kernel_launch: hipFuncSetAttribute failed\n"); grid = -1; return; }
        if (hipOccupancyMaxActiveBlocksPerMultiprocessor(&per_cu, (const void*)mk_fwd, NT, LDS_BYTES) != hipSuccess || per_cu < 1) fprintf(stderr, "kernel_launch: occupancy query reports %d\n", per_cu);
        (void)hipGetLastError();
        grid = cus;
    }
    if (grid < 0) return;
    if (hipMemsetAsync((char*)d_ws + WS_CTL, 0, CTL_ZERO_BYTES, stream) != hipSuccess) return;
    Args a{};
    for (int i = 0; i < 27; ++i) a.in[i] = (const float*)d_in[i];
    a.out = (float*)d_out; a.ws = (unsigned char*)d_ws;
#define MK(lo_, hi_, li_) do { a.ph_lo = (lo_); a.ph_hi = (hi_); a.li = (li_); hipLaunchKernelGGL(mk_fwd, dim3(grid), dim3(NT), LDS_BYTES, stream, a); } while (0)
#define NAIVE(PH, L) hipLaunchKernelGGL(naive_mix<PH>, dim3(2048), dim3(NTN), 1024, stream, a, L)
    MK(0, PH_END, 0);
}
```

```cpp
#include <hip/hip_runtime.h>
#include <cstdint>
#include <cstdio>

typedef unsigned short bf16;
constexpr int NB = 16, S = 2048, D = 1024, M = NB * S, DEPTH = 2;
constexpr int INC = 3344, FF = 2816, PLE = 256;
constexpr float EPS = 1e-6f;
constexpr int NWAVES = 8, NT = NWAVES * 64;
constexpr int PJ = 3328, NPROJ = 3584;
constexpr int O_Z = 0, O_XBC = 512, O_DQ = 1536, O_DK = 1792, O_DV = 2048, O_MQ = 2304, O_MK = 2560, O_MV = 2816, O_MO = 3072;
constexpr int SM_DT = 0, SM_MI = 8, SM_MF = 12;

constexpr size_t MiB = 1u << 20;
constexpr size_t WS_CTL = 0, CTL_ZERO_BYTES = 1 * MiB;
constexpr size_t WS_W = 1 * MiB;
constexpr size_t W_IN = 0, W_OUT = 7 * MiB, W_GU = 9 * MiB, W_DN = 20 * MiB, W_PG = 25 * MiB + 512 * 1024, W_PP = 27 * MiB + 512 * 1024, W_LAYER = 28 * MiB;
constexpr size_t WS_SSQP = 57 * MiB;
constexpr size_t WS_SMALL = 59 * MiB;
constexpr size_t WS_MISC = 61 * MiB;
constexpr size_t WS_HB = 64 * MiB;
constexpr size_t WS_PROJ = 128 * MiB;
constexpr size_t WS_HID = WS_PROJ;
constexpr size_t WS_MIX = 336 * MiB;
constexpr size_t WS_PP = WS_MIX;
constexpr size_t WS_PB = 400 * MiB;
constexpr size_t WS_HB2 = 432 * MiB;
constexpr size_t WS_XC = 432 * MiB;
constexpr size_t WS_END = 496 * MiB;

__device__ __forceinline__ float bf2f(bf16 v) { return __uint_as_float((unsigned)v << 16); }
__device__ __forceinline__ bf16 f2bf(float f) { unsigned u = __float_as_uint(f); return (bf16)((u + 0x7fffu + ((u >> 16) & 1u)) >> 16); }
__device__ __forceinline__ float sigmoidf_(float x) { return 1.f / (1.f + __expf(-x)); }
__device__ __forceinline__ float siluf_(float x) { return x * sigmoidf_(x); }
__device__ __forceinline__ float softplusf_(float x) { return x > 20.f ? x : log1pf(expf(x)); }
__device__ __forceinline__ float logsigmoidf_(float x) { return fminf(x, 0.f) - log1pf(expf(-fabsf(x))); }
__device__ __forceinline__ float log1pexp_fast(float x) { const float y = __expf(x); const float r = (y < 0.03125f) ? y * (1.f - y * (0.5f - y * 0.33333334f)) : __logf(1.f + y); return x > 15.f ? x : r; }
__device__ __forceinline__ float softplus_fast(float x) { return log1pexp_fast(x); }
__device__ __forceinline__ float logsigmoid_fast(float x) { return fminf(x, 0.f) - log1pexp_fast(-fabsf(x)); }
__device__ __forceinline__ int lane_id_asm() { int l; asm volatile("v_mbcnt_lo_u32_b32 %0, -1, 0\n\tv_mbcnt_hi_u32_b32 %0, -1, %0" : "=v"(l)); return l; }
__device__ __forceinline__ float shfl_f(float v, int src) { return __int_as_float(__builtin_amdgcn_ds_bpermute(src << 2, __float_as_int(v))); }
__device__ __forceinline__ float wave_sum(float v) {
#pragma unroll
    for (int o = 1; o < 64; o <<= 1) v += __shfl_xor(v, o);
    return v;
}
__device__ __forceinline__ float wave_sum_l(float v, int lane) {
#pragma unroll
    for (int o = 1; o < 64; o <<= 1) v += shfl_f(v, lane ^ o);
    return v;
}
__constant__ unsigned char T5_BUCKET[128] = {0,1,2,3,4,5,6,7,8,9,10,11,12,13,14,15,16,16,16,17,17,18,18,18,19,19,19,20,20,20,20,21,21,21,21,22,22,22,22,22,23,23,23,23,23,23,24,24,24,24,24,24,25,25,25,25,25,25,25,26,26,26,26,26,26,26,26,27,27,27,27,27,27,27,27,27,27,28,28,28,28,28,28,28,28,28,28,29,29,29,29,29,29,29,29,29,29,29,29,30,30,30,30,30,30,30,30,30,30,30,30,30,30,31,31,31,31,31,31,31,31,31,31,31,31,31,31,31};
enum { I_X = 0, I_P, I_N1W, I_WIN, I_CONVW, I_CONVB, I_DTB, I_ALOG, I_SSDD, I_SSDNW, I_LQ1, I_LK1, I_LQ2, I_LK2, I_DNW, I_RELB, I_MIB, I_MFB, I_MNW, I_WOUT, I_N2W, I_WG, I_WU, I_WD, I_PGW, I_PPW, I_FNW };
struct Args { const float* in[27]; float* out; unsigned char* ws; int ph_lo, ph_hi, li, pad; };
namespace pg8 {
#define PG8_LAS __attribute__((address_space(3)))
typedef unsigned short bf16_t;
typedef short bf16x8 __attribute__((ext_vector_type(8)));
typedef float f32x4 __attribute__((ext_vector_type(4)));
typedef unsigned u32x4 __attribute__((ext_vector_type(4)));
constexpr int BM = 256, BK = 64, HALF = 128, HTB = HALF * BK * 2  , STAGE_BYTES = 8 * HTB, NXCD = 8;

__host__ __device__ __forceinline__ int lds_byte(int r, int c) { const int st = (r >> 4) * 2 + (c >> 5), rr = r & 15, cc = c & 31, ob = rr * 64 + cc * 2; return st * 1024 + (ob ^ (((ob >> 9) & 1) << 5)); }
__host__ __device__ __forceinline__ void stage_rc(int b, int& R, int& C) { const int st = b / 1024, sb = b % 1024, swz = sb ^ (((sb >> 9) & 1) << 5); R = (st >> 1) * 16 + swz / 64; C = (st & 1) * 32 + (swz % 64) / 2; }
__host__ __device__ __forceinline__ int perm32(int rho) { const int n = rho >> 4, i = rho & 15; return 8 * (i >> 2) + 4 * n + (i & 3); }

struct Unit { int pm, pn, ord; };
struct Gemm { const bf16_t* A; const bf16_t* Bt; int M, N, K; };

struct StaticOrder {
    int nM, nN, nwg, G, c, WGM;
    __host__ __device__ void init(int M, int N, int G_, int c_, int wgm_ = 4) { nM = M / BM; nN = N / BM; nwg = nM * nN; G = G_; c = c_; WGM = wgm_; }
    __host__ __device__ bool next(int i, Unit& u) const {
        const long L = (long)i * G + c; if (L >= nwg) return false;
        int wgid = (int)L; { const int q = nwg / NXCD, r = nwg % NXCD, xcd = wgid % NXCD, off = wgid / NXCD; wgid = (xcd < r ? xcd * (q + 1) : r * (q + 1) + (xcd - r) * q) + off; }
        const int nig = WGM * nN, gid = wgid / nig, fm = gid * WGM, gsz = (nM - fm) < WGM ? (nM - fm) : WGM;
        u.pm = fm + ((wgid % nig) % gsz); u.pn = (wgid % nig) / gsz; return true;
    }
    __device__ __forceinline__ void a_ready(const Unit&) const {}
    __device__ __forceinline__ void done(const Unit&) const {}
};

__device__ __forceinline__ unsigned cvt_pk_bf16(float lo, float hi) { unsigned r; asm volatile("v_cvt_pk_bf16_f32 %0, %1, %2" : "=v"(r) : "v"(lo), "v"(hi)); return r; }
typedef float f32x2 __attribute__((ext_vector_type(2)));
__device__ __forceinline__ f32x2 gelu_pk(f32x2 v) {
    const f32x2 av = __builtin_elementwise_abs(v), d = av * 0.2316418882f + 1.0f;
    f32x2 t; t.x = __builtin_amdgcn_rcpf(d.x); t.y = __builtin_amdgcn_rcpf(d.y);
    f32x2 q = t * 0.5307027145f + (-0.7265760135f); q = q * t + 0.7107068705f; q = q * t + (-0.142248368f); q = q * t + 0.127414796f; q = q * t;
    const f32x2 s = (v * v) * (-0.72134752044f);
    f32x2 e; e.x = __builtin_amdgcn_exp2f(s.x); e.y = __builtin_amdgcn_exp2f(s.y);
    const f32x2 m = v * (q * e), r = v - m;
    f32x2 o; o.x = v.x < 0.f ? m.x : r.x; o.y = v.y < 0.f ? m.y : r.y; return o;
}

template <int ACT  > struct EpiBf16 {
    static constexpr bool PERM = true, AFTER_DRAIN = false; static_assert(ACT == 0 || ACT == 1, "EpiBf16: ACT is 0 (none) or 1 (gelu_pk)");
    bf16_t* O; int ldc; const float* bias; int split_cols; size_t split_stride; float scale0;
    __device__ __forceinline__ void operator()(const f32x4 (&acc)[2][2][4][2], const Unit& u, int wr, int wc, int fr, int fq) const {
        const int row0 = u.pm * BM + wr * 64 + fr; int colt = u.pn * BM; bf16_t* base = O;
        float sc = 1.f; if (split_cols) { const int t = colt / split_cols; base += (size_t)t * split_stride; colt -= t * split_cols; if (t == 0) sc = scale0; }
        const int col0 = colt + wc * 32 + 8 * fq, bcol0 = u.pn * BM + wc * 32 + 8 * fq;
        f32x4 bv[2][2];
#pragma unroll
        for (int bj = 0; bj < 2; ++bj)
#pragma unroll
            for (int n = 0; n < 2; ++n) bv[bj][n] = bias ? *(const f32x4*)(bias + bcol0 + bj * HALF + 4 * n) : (f32x4){0.f, 0.f, 0.f, 0.f};
#pragma unroll
        for (int ai = 0; ai < 2; ++ai)
#pragma unroll
            for (int m = 0; m < 4; ++m) { bf16_t* rowp = base + (size_t)(row0 + ai * HALF + m * 16) * ldc + col0;
#pragma unroll
                for (int bj = 0; bj < 2; ++bj) { f32x4 v0 = acc[ai][bj][m][0] + bv[bj][0], v1 = acc[ai][bj][m][1] + bv[bj][1];
                    if (ACT == 1) { f32x2 a = gelu_pk((f32x2){v0[0], v0[1]}), b = gelu_pk((f32x2){v0[2], v0[3]}), c = gelu_pk((f32x2){v1[0], v1[1]}), d = gelu_pk((f32x2){v1[2], v1[3]});
                        v0 = (f32x4){a.x, a.y, b.x, b.y}; v1 = (f32x4){c.x, c.y, d.x, d.y}; }
                    v0 = v0 * sc; v1 = v1 * sc; u32x4 w; w.x = cvt_pk_bf16(v0[0], v0[1]); w.y = cvt_pk_bf16(v0[2], v0[3]); w.z = cvt_pk_bf16(v1[0], v1[1]); w.w = cvt_pk_bf16(v1[2], v1[3]);
                    *(u32x4*)(rowp + bj * HALF) = w; } }
    }
};
typedef unsigned u32x2 __attribute__((ext_vector_type(2)));
constexpr float RMS_EPS = 1e-6f;
__device__ __forceinline__ float row_rstd(const float* ssqp, int row, int fr_, int fq) {
    const f32x4 p = *(const f32x4*)(ssqp + (size_t)row * 16 + 4 * fq);
    float s = (p[0] + p[1]) + (p[2] + p[3]);
    const int ln_ = fr_ | (fq << 4); s += shfl_f(s, ln_ ^ 16); s += shfl_f(s, ln_ ^ 32);
    return rsqrtf(s * (1.0f / 1024.0f) + RMS_EPS);
}
__device__ __forceinline__ float fast_sigmoid(float x) { return __builtin_amdgcn_rcpf(1.0f + __expf(-x)); }
struct EpiProj {
    static constexpr bool PERM = true, AFTER_DRAIN = false;
    bf16_t* proj; float* small_; const PG8_LAS float* rtab;
    __device__ __forceinline__ void operator()(const f32x4 (&acc)[2][2][4][2], const Unit& u, int wr, int wc, int fr, int fq) const {
        const int row0 = u.pm * BM + wr * 64 + fr;
#pragma unroll
        for (int ai = 0; ai < 2; ++ai)
#pragma unroll
            for (int m = 0; m < 4; ++m) {
                const int row = row0 + ai * HALF + m * 16; const float rs = rtab[u.ord * BM + ai * HALF + wr * 64 + m * 16 + fr] * ((u.pn == 6) ? 0.25503486f : 1.0f);
                if (u.pn < 13) {
                    bf16_t* rowp = proj + (size_t)row * 3328 + u.pn * BM + wc * 32 + 8 * fq;
#pragma unroll
                    for (int bj = 0; bj < 2; ++bj) { const f32x4 v0 = acc[ai][bj][m][0] * rs, v1 = acc[ai][bj][m][1] * rs;
                        u32x4 w; w.x = cvt_pk_bf16(v0[0], v0[1]); w.y = cvt_pk_bf16(v0[2], v0[3]); w.z = cvt_pk_bf16(v1[0], v1[1]); w.w = cvt_pk_bf16(v1[2], v1[3]);
                        *(u32x4*)(rowp + bj * HALF) = w; }
                } else if (wc == 0 && fq < 2) {
                    float* sp = small_ + (size_t)row * 16 + 8 * fq;
                    *(f32x4*)sp = acc[ai][0][m][0] * rs; *(f32x4*)(sp + 4) = acc[ai][0][m][1] * rs;
                }
            }
    }
};
struct EpiGateUp {
    static constexpr bool PERM = true, AFTER_DRAIN = false;
    bf16_t* hid; const PG8_LAS float* rtab;
    __device__ __forceinline__ void operator()(const f32x4 (&acc)[2][2][4][2], const Unit& u, int wr, int wc, int fr, int fq) const {
        const int row0 = u.pm * BM + wr * 64 + fr;
#pragma unroll
        for (int ai = 0; ai < 2; ++ai)
#pragma unroll
            for (int m = 0; m < 4; ++m) {
                const int row = row0 + ai * HALF + m * 16; const float rs = rtab[u.ord * BM + ai * HALF + wr * 64 + m * 16 + fr];
                float h[8];
#pragma unroll
                for (int n = 0; n < 2; ++n)
#pragma unroll
                    for (int j = 0; j < 4; ++j) { const float g = acc[ai][0][m][n][j] * rs, up = acc[ai][1][m][n][j] * rs; h[4 * n + j] = g * fast_sigmoid(g) * up; }
                u32x4 w; w.x = cvt_pk_bf16(h[0], h[1]); w.y = cvt_pk_bf16(h[2], h[3]); w.z = cvt_pk_bf16(h[4], h[5]); w.w = cvt_pk_bf16(h[6], h[7]);
                *(u32x4*)(hid + (size_t)row * 2816 + u.pn * HALF + wc * 32 + 8 * fq) = w;
            }
    }
};
template <int MODE, bool BASEF32> struct EpiRes {
    static constexpr bool PERM = true, AFTER_DRAIN = false;
    const void* base; bf16_t* out; float* ssqp; const bf16_t* pp;
    __device__ __forceinline__ void operator()(const f32x4 (&acc)[2][2][4][2], const Unit& u, int wr, int wc, int fr, int fq) const {
        const int row0 = u.pm * BM + wr * 64 + fr, col0 = u.pn * BM + wc * 32 + 8 * fq;
#pragma unroll
        for (int ai = 0; ai < 2; ++ai)
#pragma unroll
            for (int m = 0; m < 4; ++m) {
                const int row = row0 + ai * HALF + m * 16; const size_t off = (size_t)row * 1024 + col0; float ss = 0.f;
                float b[2][8]; u32x4 pw[2];
#pragma unroll
                for (int bj = 0; bj < 2; ++bj) { const size_t o = off + bj * HALF;
                    if (BASEF32) { const f32x4 b0 = *(const f32x4*)((const float*)base + o), b1 = *(const f32x4*)((const float*)base + o + 4);
                        b[bj][0] = b0[0]; b[bj][1] = b0[1]; b[bj][2] = b0[2]; b[bj][3] = b0[3]; b[bj][4] = b1[0]; b[bj][5] = b1[1]; b[bj][6] = b1[2]; b[bj][7] = b1[3]; }
                    else { const u32x4 w = *(const u32x4*)((const bf16_t*)base + o);
#pragma unroll
                        for (int j = 0; j < 4; ++j) { b[bj][2 * j] = __uint_as_float(w[j] << 16); b[bj][2 * j + 1] = __uint_as_float(w[j] & 0xffff0000u); } }
                    if (MODE == 2) pw[bj] = *(const u32x4*)(pp + o); }
#pragma unroll
                for (int bj = 0; bj < 2; ++bj) { const size_t o = off + bj * HALF; float v[8];
#pragma unroll
                    for (int j = 0; j < 8; ++j) { float a = acc[ai][bj][m][j >> 2][j & 3];
                        if (MODE == 2) { const unsigned w = pw[bj][j >> 1]; a = fast_sigmoid(a) * __uint_as_float((j & 1) ? (w & 0xffff0000u) : (w << 16)); }
                        v[j] = b[bj][j] + a; ss += v[j] * v[j]; }
                    u32x4 hw; hw.x = cvt_pk_bf16(v[0], v[1]); hw.y = cvt_pk_bf16(v[2], v[3]); hw.z = cvt_pk_bf16(v[4], v[5]); hw.w = cvt_pk_bf16(v[6], v[7]);
                    *(u32x4*)(out + o) = hw; }
                if (MODE != 1) { const int ln_ = fr | (fq << 4); ss += shfl_f(ss, ln_ ^ 16); ss += shfl_f(ss, ln_ ^ 32); if (fq == 0) ssqp[(size_t)row * 16 + u.pn * 4 + wc] = ss; }
            }
    }
};
template <class Epi, class Sched, bool ALIGN_EPI = false, bool SP2 = false>
__device__ __forceinline__ void gemm_phase(const int wave_s, PG8_LAS unsigned char* lds, const Gemm g, const Sched& S, const Epi& E) {
    const int tid_ = wave_s * 64 + lane_id_asm();
    const int tid = tid_, wid = __builtin_amdgcn_readfirstlane(tid >> 6), lane = tid & 63, wr = wid >> 2, wc = wid & 3, fr = lane & 15, fq = lane >> 4;
    const int K = g.K, nt = K / BK;
    unsigned voffA[2], voffB[2];
#pragma unroll
    for (int i = 0; i < 2; ++i) { int R, C; stage_rc(tid * 16 + i * 8192, R, C); const int Rb = Epi::PERM ? ((R & ~31) + perm32(R & 31)) : R;
        voffA[i] = (unsigned)(R * K + C) * 2u; voffB[i] = (unsigned)(Rb * K + C) * 2u; }
    const size_t kstep = (size_t)(BK * 2);
    const size_t hstep = (size_t)HALF * K * 2;
    const size_t tstep = 2 * hstep;
    const unsigned ldsw = (unsigned)wid * 1024u;
    const int aoff = lds_byte(wr * 64 + fr, fq * 8), boff = lds_byte(wc * 32 + fr, fq * 8);
#define PG8_SA(b, h) (((b) * 2 + (h)) * HTB)
#define PG8_SB(b, h) ((4 + (b) * 2 + (h)) * HTB)
#define PG8_STAGE(bufoff, gbase, voff) do { _Pragma("unroll") for (int _i = 0; _i < 2; ++_i) \
        __builtin_amdgcn_global_load_lds((const unsigned*)((const char*)(gbase) + (voff)[_i]), (PG8_LAS unsigned*)(lds + (bufoff) + ldsw + _i * 8192), 16, 0, 0); } while (0)
#define PG8_LDA(dst, b, h) do { _Pragma("unroll") for (int m = 0; m < 4; ++m) _Pragma("unroll") for (int k = 0; k < 2; ++k) dst[m][k] = *(const PG8_LAS bf16x8*)(lds + PG8_SA(b, h) + aoff + m * 2048 + k * 1024); } while (0)
#define PG8_LDB(dst, b, h) do { _Pragma("unroll") for (int n = 0; n < 2; ++n) _Pragma("unroll") for (int k = 0; k < 2; ++k) dst[n][k] = *(const PG8_LAS bf16x8*)(lds + PG8_SB(b, h) + boff + n * 2048 + k * 1024); } while (0)
#define PG8_MMA(ai, bj, At, Bt) do { __builtin_amdgcn_s_setprio(1); _Pragma("unroll") for (int m = 0; m < 4; ++m) _Pragma("unroll") for (int n = 0; n < 2; ++n) _Pragma("unroll") for (int k = 0; k < 2; ++k) \
        acc[ai][bj][m][n] = __builtin_amdgcn_mfma_f32_16x16x32_bf16(Bt[n][k], At[m][k], acc[ai][bj][m][n], 0, 0, 0); __builtin_amdgcn_s_setprio(0); } while (0)
#define PG8_WAIT_V(n) asm volatile("s_waitcnt vmcnt(" #n ")" ::: "memory")
#define PG8_WAIT_L(n) asm volatile("s_waitcnt lgkmcnt(" #n ")" ::: "memory")
#define PG8_BAR __builtin_amdgcn_s_barrier()
#define PG8_SCHED __builtin_amdgcn_sched_barrier(0)
    Unit cur, nxt; int ui = 0;
    if (!S.next(0, cur)) return;
    cur.ord = 0;
    f32x4 acc[2][2][4][2];
#pragma unroll
    for (int a = 0; a < 2; ++a)
#pragma unroll
        for (int b = 0; b < 2; ++b)
#pragma unroll
            for (int m = 0; m < 4; ++m)
#pragma unroll
                for (int n = 0; n < 2; ++n) acc[a][b][m][n] = (f32x4){0.f, 0.f, 0.f, 0.f};
    bf16x8 At[4][2], B0[2][2], B1[2][2];
    const char* cA = (const char*)g.A + (size_t)cur.pm * tstep; const char* cB = (const char*)g.Bt + (size_t)cur.pn * tstep;
    S.a_ready(cur);
    if constexpr (SP2) {
        PG8_STAGE(PG8_SB(0, 0), cB, voffB); PG8_STAGE(PG8_SB(0, 1), cB + hstep, voffB); PG8_STAGE(PG8_SA(0, 0), cA, voffA); PG8_STAGE(PG8_SA(0, 1), cA + hstep, voffA);
        if (wr == 1) PG8_BAR;
        PG8_WAIT_V(2); PG8_BAR;
        PG8_STAGE(PG8_SB(1, 0), cB + kstep, voffB); PG8_STAGE(PG8_SA(1, 0), cA + kstep, voffA); PG8_STAGE(PG8_SB(1, 1), cB + hstep + kstep, voffB);
        PG8_WAIT_V(6); PG8_BAR;
    } else {
        PG8_STAGE(PG8_SB(0, 0), cB, voffB); PG8_STAGE(PG8_SA(0, 0), cA, voffA); PG8_STAGE(PG8_SB(0, 1), cB + hstep, voffB); PG8_STAGE(PG8_SA(0, 1), cA + hstep, voffA);
        if (wr == 1) PG8_BAR;
        PG8_WAIT_V(4); PG8_BAR;
        PG8_STAGE(PG8_SB(1, 0), cB + kstep, voffB); PG8_STAGE(PG8_SA(1, 0), cA + kstep, voffA); PG8_STAGE(PG8_SB(1, 1), cB + hstep + kstep, voffB);
        PG8_WAIT_V(6); PG8_BAR;
    }
    for (;;) {
        const bool has_next = S.next(ui + 1, nxt); nxt.ord = ui + 1;
        const char* nA = has_next ? (const char*)g.A + (size_t)nxt.pm * tstep : cA; const char* nB = has_next ? (const char*)g.Bt + (size_t)nxt.pn * tstep : cB;
        for (int t = 0; t < nt; t += 2) {
            const bool last = (t == nt - 2);
            const char* a1 = cA + (size_t)(t + 1) * kstep;
            const char* a2 = last ? nA : cA + (size_t)(t + 2) * kstep; const char* b2 = last ? nB : cB + (size_t)(t + 2) * kstep;
            const char* a3 = a2 + kstep; const char* b3 = b2 + kstep;
            if (last && has_next) S.a_ready(nxt);
            if constexpr (SP2) {
            PG8_LDB(B0, 0, 0); PG8_LDB(B1, 0, 1); PG8_SCHED; PG8_LDA(At, 0, 0); PG8_STAGE(PG8_SA(1, 1), a1 + hstep, voffA);
            PG8_WAIT_V(8); PG8_WAIT_L(0); PG8_BAR; PG8_MMA(0, 0, At, B0); PG8_MMA(0, 1, At, B1); PG8_BAR; PG8_SCHED;
            PG8_LDA(At, 0, 1); PG8_STAGE(PG8_SB(0, 0), b2, voffB); PG8_STAGE(PG8_SB(0, 1), b2 + hstep, voffB); PG8_STAGE(PG8_SA(0, 0), a2, voffA);
            PG8_WAIT_V(8); PG8_WAIT_L(0); PG8_BAR; PG8_MMA(1, 0, At, B0); PG8_MMA(1, 1, At, B1); PG8_BAR; PG8_SCHED;
            PG8_LDB(B0, 1, 0); PG8_LDB(B1, 1, 1); PG8_SCHED; PG8_LDA(At, 1, 0); PG8_STAGE(PG8_SA(0, 1), a2 + hstep, voffA);
            PG8_WAIT_V(8); PG8_WAIT_L(0); PG8_BAR; PG8_MMA(0, 0, At, B0); PG8_MMA(0, 1, At, B1); PG8_BAR; PG8_SCHED;
            PG8_LDA(At, 1, 1); PG8_STAGE(PG8_SB(1, 0), b3, voffB); PG8_STAGE(PG8_SB(1, 1), b3 + hstep, voffB); PG8_STAGE(PG8_SA(1, 0), a3, voffA);
            PG8_WAIT_V(8); PG8_WAIT_L(0); PG8_BAR; PG8_MMA(1, 0, At, B0); PG8_MMA(1, 1, At, B1); PG8_BAR; PG8_SCHED;
            } else {
            PG8_LDB(B0, 0, 0); PG8_SCHED; PG8_LDA(At, 0, 0); PG8_STAGE(PG8_SA(1, 1), a1 + hstep, voffA);
            PG8_WAIT_L(8); PG8_BAR; PG8_WAIT_L(0); PG8_MMA(0, 0, At, B0); PG8_BAR; PG8_SCHED;
            PG8_LDB(B1, 0, 1); PG8_STAGE(PG8_SB(0, 0), b2, voffB);
            PG8_BAR; PG8_WAIT_L(0); PG8_MMA(0, 1, At, B1); PG8_BAR;
            PG8_LDA(At, 0, 1); PG8_STAGE(PG8_SA(0, 0), a2, voffA);
            PG8_BAR; PG8_WAIT_L(0); PG8_MMA(1, 0, At, B0); PG8_BAR; PG8_SCHED;
            PG8_STAGE(PG8_SB(0, 1), b2 + hstep, voffB);
            PG8_WAIT_V(6); PG8_BAR; PG8_MMA(1, 1, At, B1); PG8_BAR;
            PG8_LDB(B0, 1, 0); PG8_SCHED; PG8_LDA(At, 1, 0); PG8_STAGE(PG8_SA(0, 1), a2 + hstep, voffA);
            PG8_WAIT_L(8); PG8_BAR; PG8_WAIT_L(0); PG8_MMA(0, 0, At, B0); PG8_BAR; PG8_SCHED;
            PG8_LDB(B1, 1, 1); PG8_STAGE(PG8_SB(1, 0), b3, voffB);
            PG8_BAR; PG8_WAIT_L(0); PG8_MMA(0, 1, At, B1); PG8_BAR;
            PG8_LDA(At, 1, 1); PG8_STAGE(PG8_SA(1, 0), a3, voffA);
            PG8_BAR; PG8_WAIT_L(0); PG8_MMA(1, 0, At, B0); PG8_BAR; PG8_SCHED;
            PG8_STAGE(PG8_SB(1, 1), b3 + hstep, voffB);
            PG8_WAIT_V(6); PG8_BAR; PG8_MMA(1, 1, At, B1); PG8_BAR;
            }
        }
        if constexpr (ALIGN_EPI) { if (wr == 0) PG8_BAR; }
        if constexpr (!Epi::AFTER_DRAIN) { const int l2_ = lane_id_asm(); E(acc, cur, wr, wc, l2_ & 15, l2_ >> 4); S.done(cur); }
        if (!has_next) break;
#pragma unroll
        for (int a = 0; a < 2; ++a)
#pragma unroll
            for (int b = 0; b < 2; ++b)
#pragma unroll
                for (int m = 0; m < 4; ++m)
#pragma unroll
                    for (int n = 0; n < 2; ++n) acc[a][b][m][n] = (f32x4){0.f, 0.f, 0.f, 0.f};
        cur = nxt; cA = nA; cB = nB; ++ui;
        if constexpr (ALIGN_EPI) { if (wr == 1) PG8_BAR; }
    }
    PG8_WAIT_V(0);
    if constexpr (!ALIGN_EPI) { if (wr == 0) PG8_BAR; }
    PG8_BAR;
    if constexpr (Epi::AFTER_DRAIN) { E.fused(acc, cur, wr, wc, fr, fq, lds, wid, lane); S.done(cur); }
#undef PG8_SA
#undef PG8_SB
#undef PG8_STAGE
#undef PG8_LDA
#undef PG8_LDB
#undef PG8_MMA
#undef PG8_WAIT_V
#undef PG8_WAIT_L
#undef PG8_BAR
#undef PG8_SCHED
}
}
#define GAS __attribute__((address_space(1)))
#define LAS __attribute__((address_space(3)))
typedef unsigned v4u __attribute__((ext_vector_type(4)));
typedef float f32x4 __attribute__((ext_vector_type(4)));
#define XB_TMO      128
#define XB_XCNT(j)  (256  + 64 * (j))
#define XB_XSUB(j)  (1280 + 64 * (j))
#define XB_XGEN(j)  (2304 + 64 * (j))
#define XB_TOP      3328
#define XB_TOPGEN   3392
#define XCD_BAR_WORDS 3456
#define XB_SPIN_CAP (1u << 18)

__device__ __forceinline__ unsigned xb_ld(unsigned* p)              { return __hip_atomic_load(p, __ATOMIC_RELAXED, __HIP_MEMORY_SCOPE_AGENT); }
__device__ __forceinline__ unsigned xb_add(unsigned* p, unsigned v) { return __hip_atomic_fetch_add(p, v, __ATOMIC_RELAXED, __HIP_MEMORY_SCOPE_AGENT); }
__device__ __forceinline__ unsigned xb_xcc_id() { return (unsigned)__builtin_amdgcn_s_getreg((3 << 11) | 20) & 0xFu; }
#define XB_SPIN(cond, bar) do { unsigned _sp = 0; while (cond) { __builtin_amdgcn_s_sleep(1); \
    if ((++_sp & 255u) == 0u) { if (xb_ld(&(bar)[XB_TMO])) break; if (_sp > XB_SPIN_CAP) { atomicAdd(&(bar)[XB_TMO], 1u); break; } } } } while (0)

struct XcdBarrier {
    unsigned* bar; unsigned x;
    volatile LAS unsigned* st;
    int w;
};

__device__ __forceinline__ XcdBarrier xcd_barrier_post(unsigned* bar, volatile LAS unsigned* st, int w) {
    XcdBarrier b; b.bar = bar; b.x = xb_xcc_id(); b.st = st; b.w = w;
    if (w == 0 && lane_id_asm() == 0) (void)xb_add(&bar[XB_XCNT(b.x)], 1u);
    return b;
}
__device__ __forceinline__ void xcd_barrier_complete(unsigned* bar, unsigned x, unsigned& nloc, unsigned& nx) {
    const unsigned G = gridDim.x * gridDim.y * gridDim.z;
    unsigned sum, cnt, mine, sp = 0u;
    for (;;) {
        sum = 0u; cnt = 0u; mine = 0u;
#pragma unroll
        for (unsigned j = 0; j < 16; ++j) { const unsigned c = xb_ld(&bar[XB_XCNT(j)]); sum += c; cnt += (c > 0u) ? 1u : 0u; mine = (j == x) ? c : mine; }
        if (sum == G) break;
        __builtin_amdgcn_s_sleep(1);
        if ((++sp & 255u) == 0u) { if (xb_ld(&bar[XB_TMO])) break; if (sp > XB_SPIN_CAP) { atomicAdd(&bar[XB_TMO], 1u); break; } }
    }
    nloc = mine > 0u ? mine : 1u; nx = cnt > 0u ? cnt : 1u;
}

__device__ __forceinline__ void xcd_barrier(const XcdBarrier& b) {
    asm volatile("s_waitcnt vmcnt(0)" ::: "memory");
    __syncthreads();
    if (b.w == 0 && lane_id_asm() == 0) {
        unsigned* bar = b.bar;
        __builtin_amdgcn_s_waitcnt(0);
        unsigned nloc = b.st[0], nx = b.st[1];
        if (nloc == 0u) { xcd_barrier_complete(bar, b.x, nloc, nx); b.st[0] = nloc; b.st[1] = nx; }
        const unsigned old = xb_add(&bar[XB_XSUB(b.x)], 1u);
        const unsigned gen = old / nloc;
        if (old + 1u == (gen + 1u) * nloc) {
            __builtin_amdgcn_fence(__ATOMIC_RELEASE, "agent");
            asm volatile("s_waitcnt vmcnt(0)" ::: "memory");
            const unsigned og = xb_add(&bar[XB_TOP], 1u);
            const unsigned tg = og / nx;
            if (og + 1u == (tg + 1u) * nx) xb_add(&bar[XB_TOPGEN], 1u);
            else XB_SPIN(xb_ld(&bar[XB_TOPGEN]) == tg, bar);
            __builtin_amdgcn_fence(__ATOMIC_ACQUIRE, "agent");
            xb_add(&bar[XB_XGEN(b.x)], 1u);
            asm volatile("s_waitcnt vmcnt(0)" ::: "memory");
        } else {
            XB_SPIN(xb_ld(&bar[XB_XGEN(b.x)]) == gen, bar);
            __builtin_amdgcn_fence(__ATOMIC_ACQUIRE, "agent");
            asm volatile("s_waitcnt vmcnt(0)" ::: "memory");
        }
    }
    __syncthreads();
}
namespace mx {
typedef short bf16x8 __attribute__((ext_vector_type(8)));
typedef short s16x4 __attribute__((ext_vector_type(4)));
typedef float f32x16 __attribute__((ext_vector_type(16)));
typedef __bf16 bf16x2_t __attribute__((ext_vector_type(2)));
typedef float f32x2_t __attribute__((ext_vector_type(2)));
typedef unsigned u32x2m __attribute__((ext_vector_type(2)));
typedef LAS bf16* lbf;
typedef LAS float* lf32;
#define WG_BAR() __syncthreads()
#define LAUNDER(x) asm volatile("" : "+v"(x))
__device__ __forceinline__ int crow(int i, int h) { return (i & 3) + 8 * (i >> 2) + 4 * h; }
__device__ __forceinline__ unsigned cvt2(float lo, float hi) { f32x2_t v = {lo, hi}; bf16x2_t b = __builtin_convertvector(v, bf16x2_t); return __builtin_bit_cast(unsigned, b); }
__device__ __forceinline__ f32x16 zero16() { f32x16 z; for (int i = 0; i < 16; ++i) z[i] = 0.f; return z; }
typedef short v4i16_t __attribute__((ext_vector_type(4)));
__device__ __forceinline__ s16x4 tr4(lbf p) { return __builtin_bit_cast(s16x4, __builtin_amdgcn_ds_read_tr16_b64_v4i16((LAS v4i16_t*)p)); }
__device__ __forceinline__ bf16x8 frag_n(lbf img, int P, int row0, int k0, int lane) { return *(const LAS bf16x8*)(img + (row0 + (lane & 31)) * P + k0 + 8 * (lane >> 5)); }
__device__ __forceinline__ bf16x8 frag_tr(lbf img, int P, int k0, int col0, int lane) {
    const int l16 = lane & 15; lbf a = img + (k0 + 8 * (lane >> 5) + (l16 >> 2)) * P + col0 + 16 * ((lane >> 4) & 1) + 4 * (l16 & 3);
    const s16x4 lo = tr4(a), hi = tr4(a + 4 * P); return __builtin_shufflevector(lo, hi, 0, 1, 2, 3, 4, 5, 6, 7);
}
__device__ __forceinline__ bf16x8 frag_tp(lbf img, int P, int k0, int col0, int lane) {
    const int l16 = lane & 15; lbf a = img + (k0 + 4 * (lane >> 5) + (l16 >> 2)) * P + col0 + 16 * ((lane >> 4) & 1) + 4 * (l16 & 3);
    const s16x4 lo = tr4(a), hi = tr4(a + 8 * P); return __builtin_shufflevector(lo, hi, 0, 1, 2, 3, 4, 5, 6, 7);
}
template <bool ATR, bool BTR>
__device__ __forceinline__ void mma(f32x16& acc, lbf A, int PA, int a0, lbf B, int PB, int b0, int K, int lane) {
    for (int k0 = 0; k0 < K; k0 += 16) {
        const bf16x8 a = ATR ? frag_tr(A, PA, k0, a0, lane) : frag_n(A, PA, a0, k0, lane);
        const bf16x8 b = BTR ? frag_tr(B, PB, k0, b0, lane) : frag_n(B, PB, b0, k0, lane);
        acc = __builtin_amdgcn_mfma_f32_32x32x16_bf16(a, b, acc, 0, 0, 0);
    }
}
__device__ __forceinline__ v4u pack8(const float (&v)[8]) { return (v4u){cvt2(v[0], v[1]), cvt2(v[2], v[3]), cvt2(v[4], v[5]), cvt2(v[6], v[7])}; }
__device__ __forceinline__ void scan_add128(float& a, float& b, int lane) {
    const float pair = a + b; float x = pair;
#pragma unroll
    for (int o = 1; o < 64; o <<= 1) { const float y = shfl_f(x, lane - o); if (lane >= o) x += y; }
    const float excl = x - pair; a = excl + a; b = excl + pair;
}
__device__ __forceinline__ void scan_max128(float& a, float& b, int lane) {
    const float pair = fmaxf(a, b); float x = pair;
#pragma unroll
    for (int o = 1; o < 64; o <<= 1) { const float y = shfl_f(x, lane - o); if (lane >= o) x = fmaxf(x, y); }
    float excl = shfl_f(x, lane - 1); if (lane == 0) excl = -3.0e38f;
    a = fmaxf(excl, a); b = fmaxf(excl, pair);
}
__device__ __forceinline__ float wave_max(float v, int lane) {
#pragma unroll
    for (int o = 1; o < 64; o <<= 1) v = fmaxf(v, shfl_f(v, lane ^ o));
    return v;
}
__device__ __forceinline__ void unpack8(const v4u w, float (&f)[8]) {
#pragma unroll
    for (int j = 0; j < 4; ++j) { f[2 * j] = __uint_as_float(w[j] << 16); f[2 * j + 1] = __uint_as_float(w[j] & 0xffff0000u); }
}

struct MixCtx {
    const bf16* PROJ; const float* SMALL; bf16* MIX; unsigned char* ws; const float* const* in; int L; float* states; float* cloc; bf16* prev; bf16* cprev;
};
constexpr size_t MS_CD = 0;
constexpr size_t MS_G = 16384;
constexpr size_t MS_ML = 32768;
constexpr size_t MS_MP = 49152;
constexpr size_t MS_NL = 65536;

template <int NR, class F>
__device__ __forceinline__ void conv8(const bf16* raw, int s0  , int r0, const float* cw, const float* cb, int cc, F f) {
    float w[4][8], bias[8];
#pragma unroll
    for (int k = 0; k < 4; ++k) { const f32x4 a = *(const f32x4*)(cw + k * 1024 + cc), b = *(const f32x4*)(cw + k * 1024 + cc + 4);
        w[k][0] = a.x; w[k][1] = a.y; w[k][2] = a.z; w[k][3] = a.w; w[k][4] = b.x; w[k][5] = b.y; w[k][6] = b.z; w[k][7] = b.w; }
    { const f32x4 a = *(const f32x4*)(cb + cc), b = *(const f32x4*)(cb + cc + 4); bias[0] = a.x; bias[1] = a.y; bias[2] = a.z; bias[3] = a.w; bias[4] = b.x; bias[5] = b.y; bias[6] = b.z; bias[7] = b.w; }
    float win[3][8];
#pragma unroll
    for (int k = 0; k < 3; ++k) { const int rr = r0 - 3 + k;
        if (s0 + rr >= 0) { const v4u u = *(const v4u*)(raw + (ptrdiff_t)rr * PJ); unpack8(u, win[k]); }
        else {
#pragma unroll
            for (int j = 0; j < 8; ++j) win[k][j] = 0.f; } }
#pragma unroll
    for (int i = 0; i < NR; ++i) {
        float cur[8]; { const v4u u = *(const v4u*)(raw + (ptrdiff_t)(r0 + i) * PJ); unpack8(u, cur); }
        float v[8];
#pragma unroll
        for (int j = 0; j < 8; ++j) { const float a = bias[j] + w[0][j] * win[0][j] + w[1][j] * win[1][j] + w[2][j] * win[2][j] + w[3][j] * cur[j]; v[j] = a * __builtin_amdgcn_rcpf(1.0f + __expf(-a)); }
        f(r0 + i, v);
#pragma unroll
        for (int j = 0; j < 8; ++j) { win[0][j] = win[1][j]; win[1][j] = win[2][j]; win[2][j] = cur[j]; }
    }
}

__device__ __forceinline__ void ssd_scalars(const MixCtx& c, int t0, int hd, lf32 DT, lf32 ACS, int lane) {
    const float dtb = c.in[I_DTB][c.L * 8 + hd], A = -__expf(c.in[I_ALOG][c.L * 8 + hd]);
    const float d0 = softplus_fast(c.SMALL[(size_t)(t0 + 2 * lane) * 16 + SM_DT + hd] + dtb), d1 = softplus_fast(c.SMALL[(size_t)(t0 + 2 * lane + 1) * 16 + SM_DT + hd] + dtb);
    float a0 = d0 * A, a1 = d1 * A; scan_add128(a0, a1, lane);
    DT[2 * lane] = d0; DT[2 * lane + 1] = d1; ACS[2 * lane] = a0; ACS[2 * lane + 1] = a1;
}

__device__ __forceinline__ void ssd_states_unit(const MixCtx& c, int u, LAS unsigned char* lds, int wave, int lane) {
    const int g = u & 1, bc = u >> 1, t0 = bc * 128, s0 = (bc & 15) * 128, tid = wave * 64 + lane;
    lf32 DT = (lf32)lds, ACS = (lf32)(lds + 2048);
    lbf BL = (lbf)(lds + 4096), XS = (lbf)(lds + 4096 + 40960);
    float* STATES = c.states; float* CD = (float*)(c.ws + WS_MISC + MS_CD);
    WG_BAR();
    if (wave < 4) ssd_scalars(c, t0, g * 4 + wave, DT + wave * 128, ACS + wave * 128, lane);
    WG_BAR();
    {
        const int oct = tid & 63, seg = tid >> 6;
        const float* cw = c.in[I_CONVW] + c.L * 4096; const float* cb = c.in[I_CONVB] + c.L * 1024;
        if (oct < 16) { const int cc = 512 + g * 128 + 8 * oct;
            conv8<16>(c.PROJ + (size_t)t0 * PJ + O_XBC + cc, s0, seg * 16, cw, cb, cc, [&](int l, const float (&v)[8]) { *(LAS v4u*)(BL + l * 160 + 8 * oct) = pack8(v); });
        } else if (oct < 48) { const int o2 = oct - 16, h = o2 >> 3, cc = g * 256 + 8 * o2;
            const float aend = ACS[h * 128 + 127];
            conv8<16>(c.PROJ + (size_t)t0 * PJ + O_XBC + cc, s0, seg * 16, cw, cb, cc, [&](int l, const float (&v)[8]) {
                const float sc = DT[h * 128 + l] * __expf(aend - ACS[h * 128 + l]); float w[8];
#pragma unroll
                for (int j = 0; j < 8; ++j) w[j] = v[j] * sc;
                *(LAS v4u*)(XS + l * 288 + 8 * o2) = pack8(w); });
        }
    }
    WG_BAR();
    const int pi = wave >> 2, ni = wave & 3, r = lane & 31, hh = lane >> 5;
#pragma unroll 1
    for (int h = 0; h < 4; ++h) {
        f32x16 acc = zero16();
        mma<true, true>(acc, XS, 288, h * 64 + 32 * pi, BL, 160, 32 * ni, 128, lane);
        bf16* dst = (bf16*)STATES + ((size_t)(bc * 8 + g * 4 + h) * 64 + 32 * pi) * 128 + 32 * ni + r;
#pragma unroll
        for (int i = 0; i < 16; ++i) dst[(size_t)crow(i, hh) * 128] = f2bf(acc[i]);
    }
    if (tid < 4) CD[bc * 8 + g * 4 + tid] = __expf(ACS[tid * 128 + 127]);
}

__device__ __forceinline__ void ml_summary_unit(const MixCtx& c, int u, LAS unsigned char* lds, int wave, int lane) {
    const int h = u & 3, bc = u >> 2, t0 = bc * 128, tid = wave * 64 + lane;
    lf32 EE = (lf32)lds, NPART = (lf32)(lds + 512);
    lbf VS = (lbf)(lds + 2048), KS = (lbf)(lds + 2048 + 24576);
    float* CLOC = c.cloc; unsigned char* ms = c.ws + WS_MISC;
    WG_BAR();
    if (wave == 0) {
        const float ib = c.in[I_MIB][c.L * 4 + h], fb = c.in[I_MFB][c.L * 4 + h];
        const float li0 = c.SMALL[(size_t)(t0 + 2 * lane) * 16 + SM_MI + h] + ib, li1 = c.SMALL[(size_t)(t0 + 2 * lane + 1) * 16 + SM_MI + h] + ib;
        float b0 = logsigmoid_fast(c.SMALL[(size_t)(t0 + 2 * lane) * 16 + SM_MF + h] + fb), b1 = logsigmoid_fast(c.SMALL[(size_t)(t0 + 2 * lane + 1) * 16 + SM_MF + h] + fb);
        scan_add128(b0, b1, lane);
        const float gsum = shfl_f(b1, 63);
        const float w0 = gsum - b0 + li0, w1 = gsum - b1 + li1;
        const float ml = wave_max(fmaxf(w0, w1), lane);
        EE[2 * lane] = __expf(w0 - ml); EE[2 * lane + 1] = __expf(w1 - ml);
        if (lane == 0) { ((float*)(ms + MS_G))[u] = gsum; ((float*)(ms + MS_ML))[u] = ml; }
    }
    const int oct = tid & 7, r0 = tid >> 3;
    v4u vraw[2], kraw[2];
#pragma unroll
    for (int pass = 0; pass < 2; ++pass) { const bf16* row = c.PROJ + (size_t)(t0 + r0 + 64 * pass) * PJ + h * 64 + 8 * oct; vraw[pass] = *(const v4u*)(row + O_MV); kraw[pass] = *(const v4u*)(row + O_MK); }
    WG_BAR();
#pragma unroll
    for (int pass = 0; pass < 2; ++pass) { const int s = r0 + 64 * pass; float v[8], k[8]; unpack8(vraw[pass], v); unpack8(kraw[pass], k); const float e = EE[s];
#pragma unroll
        for (int j = 0; j < 8; ++j) { v[j] *= e; k[j] *= 0.125f; }
        *(LAS v4u*)(VS + s * 96 + 8 * oct) = pack8(v); *(LAS v4u*)(KS + s * 96 + 8 * oct) = pack8(k); }
    WG_BAR();
    if (wave < 4) {
        const int ei = wave >> 1, di = wave & 1, r = lane & 31, hh = lane >> 5;
        f32x16 acc = zero16();
        mma<true, true>(acc, VS, 96, 32 * ei, KS, 96, 32 * di, 128, lane);
        bf16* dst = (bf16*)CLOC + ((size_t)u * 64 + 32 * ei) * 64 + 32 * di + r;
#pragma unroll
        for (int i = 0; i < 16; ++i) dst[crow(i, hh) * 64] = f2bf(acc[i]);
    } else {
        const int part = wave - 4; float a = 0.f;
#pragma unroll 8
        for (int s = 32 * part; s < 32 * part + 32; ++s) a += EE[s] * bf2f(KS[s * 96 + lane]);
        NPART[part * 64 + lane] = a;
    }
    WG_BAR();
    if (wave == 4) ((float*)(ms + MS_NL))[(size_t)u * 64 + lane] = (NPART[lane] + NPART[64 + lane]) + (NPART[128 + lane] + NPART[192 + lane]);
}

__device__ __forceinline__ void scan_phase(const MixCtx& c, int G, int wave, int lane) {
    const int gt = blockIdx.x * NT + wave * 64 + lane, ngt = G * NT;
    const float* STATES = c.states; const float* CD = (const float*)(c.ws + WS_MISC + MS_CD);
    float* CLOC = c.cloc; unsigned char* ms = c.ws + WS_MISC;
    const float* Gs = (const float*)(ms + MS_G); const float* ML = (const float*)(ms + MS_ML); float* MP = (float*)(ms + MS_MP); float* NL = (float*)(ms + MS_NL);
    constexpr int NS = NB * 8 * 64 * 16, NMC = NB * 4 * 64 * 16, NM = NMC + NB * 4 * 16;
    for (int e = gt; e < NS; e += ngt) {
        const int n8 = e & 15, p = (e >> 4) & 63, hd = (e >> 10) & 7, b = e >> 13;
        const size_t base8 = ((size_t)((b * 16) * 8 + hd) * 64 + p) * 16 + n8;
        const v4u* sp = (const v4u*)STATES + base8; v4u* pp = (v4u*)c.prev + base8;
        v4u sv[16]; float cd[16];
#pragma unroll
        for (int ch = 0; ch < 16; ++ch) { sv[ch] = sp[(size_t)ch * 8192]; cd[ch] = CD[(b * 16 + ch) * 8 + hd]; }
        const bool doM = e < NM, isn = e >= NMC; const int e2 = isn ? e - NMC : e;
        const int d4 = e2 & 15, er = isn ? 0 : (e2 >> 4) & 63, bh = doM ? (isn ? (e2 >> 4) : (e2 >> 10)) : 0, hm = bh & 3, bm = bh >> 2;
        const int u0 = (bm * 16) * 4 + hm;
        const u32x2m* cq = (const u32x2m*)CLOC + ((size_t)u0 * 64 + er) * 16 + d4;
        f32x4* nq = (f32x4*)(NL + (size_t)u0 * 64) + d4;
        u32x2m cv[16]; f32x4 nvv[16]; float gl[16], ml[16];
        if (doM) {
#pragma unroll
            for (int ch = 0; ch < 16; ++ch) { gl[ch] = Gs[u0 + 4 * ch]; ml[ch] = ML[u0 + 4 * ch]; if (!isn) cv[ch] = cq[(size_t)ch * 4096]; else nvv[ch] = nq[ch * 64]; }
        }
        float run[8];
#pragma unroll
        for (int q = 0; q < 8; ++q) { run[q] = 0.f; LAUNDER(run[q]); }
#pragma unroll
        for (int ch = 0; ch < 16; ++ch) { pp[(size_t)ch * 8192] = pack8(run); float sf[8]; unpack8(sv[ch], sf);
#pragma unroll
            for (int q = 0; q < 8; ++q) run[q] = run[q] * cd[ch] + sf[q]; }
        if (doM) {
            float z0 = 0.f; LAUNDER(z0); f32x4 rm = {z0, z0, z0, z0}; float m = 0.f;
            u32x2m* cp = (u32x2m*)c.cprev + ((size_t)u0 * 64 + er) * 16 + d4;
#pragma unroll
            for (int ch = 0; ch < 16; ++ch) { const float mn = fmaxf(gl[ch] + m, ml[ch]), ap = __expf(gl[ch] + m - mn), al = __expf(ml[ch] - mn);
                if (!isn) { cp[(size_t)ch * 4096] = (u32x2m){cvt2(rm.x, rm.y), cvt2(rm.z, rm.w)};
                    const f32x4 sx = {__uint_as_float(cv[ch].x << 16), __uint_as_float(cv[ch].x & 0xffff0000u), __uint_as_float(cv[ch].y << 16), __uint_as_float(cv[ch].y & 0xffff0000u)};
                    rm = rm * ap + sx * al; }
                else { nq[ch * 64] = rm; if (d4 == 0) MP[u0 + 4 * ch] = m; rm = rm * ap + nvv[ch] * al; }
                m = mn; }
        }
    }
}

template <int VAR>
__device__ __forceinline__ void ssd_group(const MixCtx& c, int bc, int g, LAS unsigned char* lds, int wave, int lane_in, unsigned (&gp)[4][8], float& ssq) {
    const int t0 = bc * 128, s0 = (bc & 15) * 128;
    lf32 DT = (lf32)lds, ACS = (lf32)(lds + 2048);
    lbf CL = (lbf)(lds + 4096), BL = (lbf)(lds + 4096 + 34816), PV = (lbf)(lds + 4096 + 2 * 34816), XD = PV;
    const float* cw = c.in[I_CONVW] + c.L * 4096; const float* cb = c.in[I_CONVB] + c.L * 1024;
    {
        int lane = lane_in; LAUNDER(lane); const int tid = wave * 64 + lane, r = lane & 31, hh = lane >> 5;
        const int li = wave >> 1, ph = wave & 1, l = 32 * li + r;
        WG_BAR();
        {
            const v4u* src = (const v4u*)(c.prev + (size_t)(bc * 8 + g * 4) * 8192);
            v4u pvr[8];
#pragma unroll
            for (int k = 0; k < 8; ++k) pvr[k] = src[tid + 512 * k];
            if (wave < 4) ssd_scalars(c, t0, g * 4 + wave, DT + wave * 128, ACS + wave * 128, lane);
            {
                const int oct = tid & 31, seg = tid >> 5; const int cc = 512 + (oct >> 4) * 256 + g * 128 + 8 * (oct & 15);
                lbf dstm = (oct < 16) ? BL : CL;
                conv8<8>(c.PROJ + (size_t)t0 * PJ + O_XBC + cc, s0, seg * 8, cw, cb, cc, [&](int l2, const float (&v)[8]) { *(LAS v4u*)(dstm + l2 * 136 + 8 * (oct & 15)) = pack8(v); });
            }
#pragma unroll
            for (int k = 0; k < 8; ++k) { const int e = tid + 512 * k, pr = e >> 4, n8 = e & 15; *(LAS v4u*)(PV + pr * 136 + 8 * n8) = pvr[k]; }
        }
        WG_BAR();
        f32x16 ag[4];
#pragma unroll
        for (int h = 0; h < 4; ++h) { ag[h] = zero16();
            if (VAR >= 2) mma<false, false>(ag[h], PV, 136, h * 64 + 32 * ph, CL, 136, 32 * li, 128, lane);
            const float el = __expf(ACS[h * 128 + l]);
#pragma unroll
            for (int i = 0; i < 16; ++i) ag[h][i] *= el; }
        WG_BAR();
        if (VAR >= 3) {
            const int oct = tid & 31, seg = tid >> 5, h = oct >> 3, cc = g * 256 + 8 * oct;
            conv8<8>(c.PROJ + (size_t)t0 * PJ + O_XBC + cc, s0, seg * 8, cw, cb, cc, [&](int l2, const float (&v)[8]) {
                const float dt = DT[h * 128 + l2]; float w[8];
#pragma unroll
                for (int j = 0; j < 8; ++j) w[j] = v[j] * dt;
                *(LAS v4u*)(XD + l2 * 288 + 8 * oct) = pack8(w); });
        }
        WG_BAR();
#pragma unroll 1
        for (int si = 0; si <= (VAR >= 4 ? li : -1); ++si) {
            f32x16 cbT = zero16();
            mma<false, false>(cbT, BL, 136, 32 * si, CL, 136, 32 * li, 128, lane);
#pragma unroll
            for (int h = 0; h < 4; ++h) {
                const float al = ACS[h * 128 + l]; float p[16];
                float as_[16];
#pragma unroll
                for (int i = 0; i < 16; ++i) as_[i] = ACS[h * 128 + 32 * si + crow(i, hh)];
#pragma unroll
                for (int i = 0; i < 16; ++i) { const int s = 32 * si + crow(i, hh); const float w = cbT[i] * __expf(fminf(al - as_[i], 0.f)); p[i] = (si < li || s <= l) ? w : 0.f; }
#pragma unroll
                for (int s2 = 0; s2 < 2; ++s2) {
                    const v4u pw = {cvt2(p[8 * s2], p[8 * s2 + 1]), cvt2(p[8 * s2 + 2], p[8 * s2 + 3]), cvt2(p[8 * s2 + 4], p[8 * s2 + 5]), cvt2(p[8 * s2 + 6], p[8 * s2 + 7])};
                    ag[h] = __builtin_amdgcn_mfma_f32_32x32x16_bf16(frag_tp(XD, 288, 32 * si + 16 * s2, h * 64 + 32 * ph, lane), __builtin_bit_cast(bf16x8, pw), ag[h], 0, 0, 0);
                }
            }
        }
#pragma unroll
        for (int h = 0; h < 4; ++h) {
            const float dsk = c.in[I_SSDD][c.L * 8 + g * 4 + h] / fmaxf(DT[h * 128 + l], 1e-20f);
            lbf xrow = XD + l * 288 + h * 64 + 32 * ph + 4 * hh;
#pragma unroll
            for (int gq = 0; gq < 4; ++gq) { const u32x2m xw = *(const LAS u32x2m*)(xrow + 8 * gq);
                ag[h][4 * gq] += __uint_as_float(xw.x << 16) * dsk; ag[h][4 * gq + 1] += __uint_as_float(xw.x & 0xffff0000u) * dsk;
                ag[h][4 * gq + 2] += __uint_as_float(xw.y << 16) * dsk; ag[h][4 * gq + 3] += __uint_as_float(xw.y & 0xffff0000u) * dsk; }
        }
        WG_BAR();
        lbf ZG = (lbf)(lds + 4096);
        {
            v4u zv[8];
#pragma unroll
            for (int k = 0; k < 8; ++k) { const int e = tid + 512 * k; zv[k] = *(const v4u*)(c.PROJ + (size_t)(t0 + (e >> 5)) * PJ + O_Z + g * 256 + 8 * (e & 31)); }
#pragma unroll
            for (int k = 0; k < 8; ++k) { const int e = tid + 512 * k; LAS u32x2m* d = (LAS u32x2m*)(ZG + (e >> 5) * 260 + 8 * (e & 31)); d[0] = (u32x2m){zv[k].x, zv[k].y}; d[1] = (u32x2m){zv[k].z, zv[k].w}; }
        }
        WG_BAR();
#pragma unroll
        for (int h = 0; h < 4; ++h) { lbf zrow = ZG + l * 260 + h * 64 + 32 * ph + 4 * hh;
#pragma unroll
            for (int gq = 0; gq < 4; ++gq) { const u32x2m zw = *(const LAS u32x2m*)(zrow + 8 * gq);
                const float z4[4] = {__uint_as_float(zw.x << 16), __uint_as_float(zw.x & 0xffff0000u), __uint_as_float(zw.y << 16), __uint_as_float(zw.y & 0xffff0000u)}; float o4[4];
#pragma unroll
                for (int k = 0; k < 4; ++k) { o4[k] = ag[h][4 * gq + k] * z4[k] * __builtin_amdgcn_rcpf(1.0f + __expf(-z4[k])); ssq += o4[k] * o4[k]; }
                gp[h][2 * gq] = cvt2(o4[0], o4[1]); gp[h][2 * gq + 1] = cvt2(o4[2], o4[3]); } }
    }
}
template <int VAR = 9>
__device__ __forceinline__ void ssd_out_unit(const MixCtx& c, int bc, LAS unsigned char* lds, int wave, int lane_in) {
    const int t0 = bc * 128;
    lf32 SQ = (lf32)lds;
    lbf ZT = (lbf)(lds + 4096);
    unsigned g0[4][8], g1[4][8]; float ss = 0.f;
#pragma unroll
    for (int a_ = 0; a_ < 4; ++a_)
#pragma unroll
        for (int b_ = 0; b_ < 8; ++b_) { g0[a_][b_] = 0u; g1[a_][b_] = 0u; }
#pragma unroll 1
    for (int g = 0; g < 2; ++g) {
        unsigned gp[4][8];
        ssd_group<VAR>(c, bc, g, lds, wave, lane_in, gp, ss);
#pragma unroll
        for (int a_ = 0; a_ < 4; ++a_)
#pragma unroll
            for (int b_ = 0; b_ < 8; ++b_) { if (g == 0) g0[a_][b_] = gp[a_][b_]; else g1[a_][b_] = gp[a_][b_]; }
    }
    if (VAR < 5) return;
    int lane = lane_in; LAUNDER(lane); const int tid = wave * 64 + lane, r = lane & 31, hh = lane >> 5;
    const int li = wave >> 1, ph = wave & 1, l = 32 * li + r;
    (void)ss; (void)SQ;
    WG_BAR();
#pragma unroll
    for (int h = 0; h < 8; ++h) { lbf orow = ZT + l * 516 + h * 64 + 32 * ph + 4 * hh;
#pragma unroll
        for (int gq = 0; gq < 4; ++gq) { const unsigned p0 = (h < 4) ? g0[h & 3][2 * gq] : g1[h & 3][2 * gq], p1 = (h < 4) ? g0[h & 3][2 * gq + 1] : g1[h & 3][2 * gq + 1];
            *(LAS u32x2m*)(orow + 8 * gq) = (u32x2m){p0, p1}; } }
    WG_BAR();
    {
        const float* nw = c.in[I_SSDNW] + c.L * 512;
        float wv[8]; { const f32x4 a = *(const f32x4*)(nw + 8 * lane), b = *(const f32x4*)(nw + 8 * lane + 4); wv[0] = a.x; wv[1] = a.y; wv[2] = a.z; wv[3] = a.w; wv[4] = b.x; wv[5] = b.y; wv[6] = b.z; wv[7] = b.w; }
#pragma unroll 4
        for (int k = 0; k < 16; ++k) { const int row = wave * 16 + k; const LAS u32x2m* sp = (const LAS u32x2m*)(ZT + row * 516 + 8 * lane);
            const u32x2m a = sp[0], b = sp[1]; float v[8]; unpack8((v4u){a.x, a.y, b.x, b.y}, v); float s2 = 0.f;
#pragma unroll
            for (int j2 = 0; j2 < 8; ++j2) s2 += v[j2] * v[j2];
            const float rs = rsqrtf(wave_sum_l(s2, lane) * (1.f / 512.f) + EPS);
#pragma unroll
            for (int j2 = 0; j2 < 8; ++j2) v[j2] *= rs * wv[j2];
            *(v4u*)(c.MIX + (size_t)(t0 + row) * 1024 + 8 * lane) = pack8(v); }
    }
}

__device__ __forceinline__ void ml_out_unit(const MixCtx& c, int u, LAS unsigned char* lds, int wave, int lane) {
    const int h = u & 3, bc = u >> 2, t0 = bc * 128, tid = wave * 64 + lane;
    lf32 RM = (lf32)lds, U = (lf32)(lds + 512), MT = (lf32)(lds + 1024), WI = (lf32)(lds + 1536), DEN = (lf32)(lds + 2048), NP = (lf32)(lds + 2560);
    lbf Q = (lbf)(lds + 4096), Kk = (lbf)(lds + 22528), VS = (lbf)(lds + 40960), CP = (lbf)(lds + 65536), AM = (lbf)(lds + 74752);
    lf32 HBf = (lf32)(lds + 4096);
    const unsigned char* ms = c.ws + WS_MISC;
    WG_BAR();
    if (wave == 0) {
        const float ib = c.in[I_MIB][c.L * 4 + h], fb = c.in[I_MFB][c.L * 4 + h];
        const float li0 = c.SMALL[(size_t)(t0 + 2 * lane) * 16 + SM_MI + h] + ib, li1 = c.SMALL[(size_t)(t0 + 2 * lane + 1) * 16 + SM_MI + h] + ib;
        float b0 = logsigmoid_fast(c.SMALL[(size_t)(t0 + 2 * lane) * 16 + SM_MF + h] + fb), b1 = logsigmoid_fast(c.SMALL[(size_t)(t0 + 2 * lane + 1) * 16 + SM_MF + h] + fb);
        scan_add128(b0, b1, lane);
        const float u0 = li0 - b0, u1 = li1 - b1; float p0 = u0, p1 = u1; scan_max128(p0, p1, lane);
        const float mp = ((const float*)(ms + MS_MP))[u];
        const float in0 = b0 + mp, in1 = b1 + mp, mt0 = fmaxf(in0, b0 + p0), mt1 = fmaxf(in1, b1 + p1);
        U[2 * lane] = u0; U[2 * lane + 1] = u1; RM[2 * lane] = b0 - mt0; RM[2 * lane + 1] = b1 - mt1; MT[2 * lane] = mt0; MT[2 * lane + 1] = mt1;
        WI[2 * lane] = __expf(in0 - mt0); WI[2 * lane + 1] = __expf(in1 - mt1);
        NP[lane] = ((const float*)(ms + MS_NL))[(size_t)u * 64 + lane];
    }
    {
        const int oct = tid & 7, r0 = tid >> 3;
#pragma unroll
        for (int pass = 0; pass < 2; ++pass) { const int s = r0 + 64 * pass; const bf16* row = c.PROJ + (size_t)(t0 + s) * PJ + h * 64 + 8 * oct;
            *(LAS v4u*)(Q + s * 72 + 8 * oct) = *(const v4u*)(row + O_MQ);
            float k[8]; unpack8(*(const v4u*)(row + O_MK), k);
            *(LAS v4u*)(Kk + s * 72 + 8 * oct) = (v4u){cvt2(k[0] * 0.125f, k[1] * 0.125f), cvt2(k[2] * 0.125f, k[3] * 0.125f), cvt2(k[4] * 0.125f, k[5] * 0.125f), cvt2(k[6] * 0.125f, k[7] * 0.125f)};
            *(LAS v4u*)(VS + s * 96 + 8 * oct) = *(const v4u*)(row + O_MV); }
        *(LAS v4u*)(CP + (tid >> 3) * 72 + 8 * (tid & 7)) = ((const v4u*)(c.cprev + (size_t)u * 4096))[tid];
    }
    WG_BAR();
    const int r = lane & 31, hh = lane >> 5;
#pragma unroll
    for (int q = 0; q < 2; ++q) { const int id = wave + 8 * q;
        if (id < 10) { int li = 0, si = 0; { int rem = id; for (li = 0; li < 4; ++li) { if (rem <= li) { si = rem; break; } rem -= li + 1; } }
            f32x16 acc = zero16();
            mma<false, false>(acc, Q, 72, 32 * li, Kk, 72, 32 * si, 64, lane);
            const int scol = 32 * si + r; const float us = U[scol]; float rm[16];
#pragma unroll
            for (int i = 0; i < 16; ++i) rm[i] = RM[32 * li + crow(i, hh)];
#pragma unroll
            for (int i = 0; i < 16; ++i) { const int l = 32 * li + crow(i, hh); const float w = acc[i] * __expf(fminf(rm[i] + us, 0.f)); AM[l * 136 + scol] = f2bf((scol <= l) ? w : 0.f); } } }
    WG_BAR();
    {
        const int l = tid >> 2, part = tid & 3; float a = 0.f;
        if (32 * part <= l) {
#pragma unroll
            for (int k = 0; k < 4; ++k) { float v[8]; unpack8(*(const LAS v4u*)(AM + l * 136 + 32 * part + 8 * k), v);
#pragma unroll
                for (int j = 0; j < 8; ++j) a += (32 * part + 8 * k + j <= l) ? v[j] : 0.f; } }
        float qn = 0.f;
#pragma unroll
        for (int k = 0; k < 2; ++k) { float v[8]; unpack8(*(const LAS v4u*)(Q + l * 72 + 16 * part + 8 * k), v);
#pragma unroll
            for (int j = 0; j < 8; ++j) qn += v[j] * NP[16 * part + 8 * k + j]; }
        a += WI[l] * qn; a += shfl_f(a, lane ^ 1); a += shfl_f(a, lane ^ 2);
        if (part == 0) DEN[l] = fmaxf(fabsf(a), __expf(-MT[l]));
    }
    WG_BAR();
    {
        const int li = wave >> 1, ei = wave & 1;
        f32x16 acc = zero16();
        mma<false, false>(acc, Q, 72, 32 * li, CP, 72, 32 * ei, 64, lane);
#pragma unroll
        for (int i = 0; i < 16; ++i) acc[i] *= WI[32 * li + crow(i, hh)];
        mma<false, true>(acc, AM, 136, 32 * li, VS, 96, 32 * ei, 32 * (li + 1), lane);
        WG_BAR();
#pragma unroll
        for (int i = 0; i < 16; ++i) { const int l = 32 * li + crow(i, hh); HBf[l * 68 + 32 * ei + r] = acc[i] / DEN[l]; }
    }
    WG_BAR();
    {
        const int l = tid >> 2, part = tid & 3; const float* nw = c.in[I_MNW] + c.L * 256 + h * 64 + 16 * part;
        float v[16]; float s = 0.f;
#pragma unroll
        for (int k = 0; k < 4; ++k) { const f32x4 x = *(const LAS f32x4*)(HBf + l * 68 + 16 * part + 4 * k); v[4 * k] = x.x; v[4 * k + 1] = x.y; v[4 * k + 2] = x.z; v[4 * k + 3] = x.w; s += (x.x * x.x + x.y * x.y) + (x.z * x.z + x.w * x.w); }
        s += shfl_f(s, lane ^ 1); s += shfl_f(s, lane ^ 2);
        const float rs = rsqrtf(s * (1.f / 64.f) + EPS);
        const bf16* orow = c.PROJ + (size_t)(t0 + l) * PJ + O_MO + h * 64 + 16 * part; bf16* dst = c.MIX + (size_t)(t0 + l) * 1024 + 768 + h * 64 + 16 * part;
#pragma unroll
        for (int k = 0; k < 2; ++k) { float o[8]; unpack8(*(const v4u*)(orow + 8 * k), o); float y[8];
#pragma unroll
            for (int j = 0; j < 8; ++j) y[j] = __builtin_amdgcn_rcpf(1.0f + __expf(-o[j])) * v[8 * k + j] * rs * nw[8 * k + j];
            *(v4u*)(dst + 8 * k) = (v4u){cvt2(y[0], y[1]), cvt2(y[2], y[3]), cvt2(y[4], y[5]), cvt2(y[6], y[7])}; }
    }
}

typedef unsigned u32x2p __attribute__((ext_vector_type(2)));
__device__ __forceinline__ float xhalf_max(float v) { const u32x2p r = __builtin_amdgcn_permlane32_swap(__float_as_uint(v), __float_as_uint(v), false, false); return fmaxf(__uint_as_float(r.x), __uint_as_float(r.y)); }
__device__ __forceinline__ float xhalf_sum(float v) { const u32x2p r = __builtin_amdgcn_permlane32_swap(__float_as_uint(v), __float_as_uint(v), false, false); return __uint_as_float(r.x) + __uint_as_float(r.y); }
struct AttnTile { f32x16 s; bool far; };
__device__ __forceinline__ void attn_qk(AttnTile& t, lbf KS, int kt, int m, const bf16x8 (&qf)[2], int lane) {
    lbf kp = KS + (kt * 32 + (lane & 31)) * 72 + m * 32 + 8 * (lane >> 5);
    t.s = zero16();
    t.s = __builtin_amdgcn_mfma_f32_32x32x16_bf16(*(const LAS bf16x8*)kp, qf[0], t.s, 0, 0, 0);
    t.s = __builtin_amdgcn_mfma_f32_32x32x16_bf16(*(const LAS bf16x8*)(kp + 16), qf[1], t.s, 0, 0, 0);
}
__device__ __forceinline__ float attn_tmax(AttnTile& t, float c1, lf32 RL, int qpos, int k0, int hh, bool diag) {
    if (t.far) { float mt = t.s[0];
#pragma unroll
        for (int i = 1; i < 16; ++i) mt = fmaxf(mt, t.s[i]);
        return mt * c1 + RL[64]; }
    float mt = -1e30f;
    lf32 rb = RL + (191 - qpos + k0 + 4 * hh);
    float bias[16];
#pragma unroll
    for (int i = 0; i < 16; ++i) bias[i] = rb[(i & 3) + 8 * (i >> 2)];
    if (diag) {
#pragma unroll
        for (int i = 0; i < 16; ++i) { const float v = (k0 + crow(i, hh) <= qpos) ? t.s[i] * c1 + bias[i] : -1e30f; t.s[i] = v; mt = fmaxf(mt, v); }
    } else {
#pragma unroll
        for (int i = 0; i < 16; ++i) { const float v = t.s[i] * c1 + bias[i]; t.s[i] = v; mt = fmaxf(mt, v); }
    }
    return mt;
}
__device__ __forceinline__ float attn_probs(AttnTile& t, float c1, lf32 LUT, float mn) {
    float ps = 0.f;
    if (t.far) { const float cbm = LUT[64] - mn;
#pragma unroll
        for (int i = 0; i < 16; ++i) { t.s[i] = __builtin_amdgcn_exp2f(t.s[i] * c1 + cbm); ps += t.s[i]; }
    } else {
#pragma unroll
        for (int i = 0; i < 16; ++i) { t.s[i] = __builtin_amdgcn_exp2f(t.s[i] - mn); ps += t.s[i]; }
    }
    return ps;
}
__device__ __forceinline__ void attn_pv(const AttnTile& t, lbf VS, int krow0, f32x16& o0, f32x16& o1, int lane) {
#pragma unroll
    for (int s2 = 0; s2 < 2; ++s2) {
        const v4u pw = {cvt2(t.s[8 * s2], t.s[8 * s2 + 1]), cvt2(t.s[8 * s2 + 2], t.s[8 * s2 + 3]), cvt2(t.s[8 * s2 + 4], t.s[8 * s2 + 5]), cvt2(t.s[8 * s2 + 6], t.s[8 * s2 + 7])};
        const bf16x8 pf = __builtin_bit_cast(bf16x8, pw);
        o0 = __builtin_amdgcn_mfma_f32_32x32x16_bf16(frag_tp(VS, 96, krow0 + 16 * s2, 0, lane), pf, o0, 0, 0, 0);
        o1 = __builtin_amdgcn_mfma_f32_32x32x16_bf16(frag_tp(VS, 96, krow0 + 16 * s2, 32, lane), pf, o1, 0, 0, 0);
    }
}
__device__ __forceinline__ void attn_unit(const MixCtx& c, int b, int h, int qb, float lam, float lam_init, LAS unsigned char* lds, int wave, int lane) {
    constexpr float LOG2E = 1.4426950408889634f;
    constexpr int STAGE = 18432 + 24576;
    const int tid = wave * 64 + lane;
    lf32 LUT = (lf32)lds;
    lf32 OB = (lf32)(lds + 1024);
    const int m = wave >> 2, qs = wave & 3, r = lane & 31, hh = lane >> 5;
    const int q0 = qb * 128 + qs * 32, qpos = q0 + r;
    WG_BAR();
    if (tid < 224) { const int d = 191 - tid; LUT[tid] = c.in[I_RELB][T5_BUCKET[d < 0 ? 0 : (d < 127 ? d : 127)] * 4 + h] * LOG2E; }
    bf16x8 qf[2];
    { const bf16* qp = c.PROJ + ((size_t)b * S + qpos) * PJ + O_DQ + h * 64 + m * 32 + 8 * hh; qf[0] = *(const bf16x8*)qp; qf[1] = *(const bf16x8*)(qp + 16); }
    f32x16 o0 = zero16(), o1 = zero16(); float mrun = -1e30f, lrun = 0.f;
    const float c1 = 0.17677669529663687f * LOG2E;
    const int soct = tid & 7, sr0 = tid >> 3;
    const bf16* kvbase = c.PROJ + ((size_t)b * S + sr0) * PJ + h * 64 + 8 * soct;
    v4u kreg[2], vreg[2];
#define ATT_LOAD(kb_) do { _Pragma("unroll") for (int pass = 0; pass < 2; ++pass) { const bf16* row = kvbase + (size_t)((kb_) * 128 + 64 * pass) * PJ; kreg[pass] = *(const v4u*)(row + O_DK); vreg[pass] = *(const v4u*)(row + O_DV); } } while (0)
#define ATT_STORE(buf_) do { LAS unsigned char* sb_ = lds + 1024 + (buf_) * STAGE; _Pragma("unroll") for (int pass = 0; pass < 2; ++pass) { const int key = sr0 + 64 * pass; \
        *(LAS v4u*)((lbf)sb_ + key * 72 + 8 * soct) = kreg[pass]; *(LAS v4u*)((lbf)(sb_ + 18432) + key * 96 + 8 * soct) = vreg[pass]; } } while (0)
    ATT_LOAD(0);
    ATT_STORE(0);
    if (qb > 0) ATT_LOAD(1);
    WG_BAR();
#pragma unroll 1
    for (int kb = 0; kb <= qb; ++kb) {
        lbf KS = (lbf)(lds + 1024 + (kb & 1) * STAGE), VS = (lbf)(lds + 1024 + (kb & 1) * STAGE + 18432);
        const int ntile = (kb < qb) ? 4 : qs + 1;
        int kt = 0;
#pragma unroll 1
        for (; kt + 1 < ntile; kt += 2) {
            const int k0 = kb * 128 + kt * 32;
            AttnTile ta, tb; ta.far = (q0 - k0 >= 144); tb.far = (q0 - (k0 + 32) >= 144);
            attn_qk(ta, KS, kt, m, qf, lane); attn_qk(tb, KS, kt + 1, m, qf, lane);
            const float mt = xhalf_max(fmaxf(attn_tmax(ta, c1, LUT, qpos, k0, hh, k0 == q0), attn_tmax(tb, c1, LUT, qpos, k0 + 32, hh, k0 + 32 == q0)));
            const float mn = fmaxf(mrun, mt);
            if (__any(mn > mrun)) { const float al = __builtin_amdgcn_exp2f(mrun - mn); lrun *= al;
#pragma unroll
                for (int i = 0; i < 16; ++i) { o0[i] *= al; o1[i] *= al; } }
            mrun = mn;
            lrun += attn_probs(ta, c1, LUT, mn) + attn_probs(tb, c1, LUT, mn);
            attn_pv(ta, VS, kt * 32, o0, o1, lane); attn_pv(tb, VS, kt * 32 + 32, o0, o1, lane);
        }
        if (kt < ntile) {
            const int k0 = kb * 128 + kt * 32;
            AttnTile ta; ta.far = (q0 - k0 >= 144);
            attn_qk(ta, KS, kt, m, qf, lane);
            const float mt = xhalf_max(attn_tmax(ta, c1, LUT, qpos, k0, hh, k0 == q0));
            const float mn = fmaxf(mrun, mt);
            if (__any(mn > mrun)) { const float al = __builtin_amdgcn_exp2f(mrun - mn); lrun *= al;
#pragma unroll
                for (int i = 0; i < 16; ++i) { o0[i] *= al; o1[i] *= al; } }
            mrun = mn;
            lrun += attn_probs(ta, c1, LUT, mn);
            attn_pv(ta, VS, kt * 32, o0, o1, lane);
        }
        if (kb < qb) {
            ATT_STORE((kb + 1) & 1);
            if (kb + 1 < qb) ATT_LOAD(kb + 2);
        }
        WG_BAR();
    }
#undef ATT_LOAD
#undef ATT_STORE
    lrun = xhalf_sum(lrun);
    { const float inv = 1.f / lrun; lf32 ob = OB + (size_t)(m * 128 + qs * 32 + r) * 68;
#pragma unroll
      for (int i = 0; i < 16; ++i) { ob[crow(i, hh)] = o0[i] * inv; ob[32 + crow(i, hh)] = o1[i] * inv; } }
    WG_BAR();
    {
        const int q = tid >> 2, part = tid & 3; const float* nw = c.in[I_DNW] + c.L * 64 + 16 * part;
        float o[16]; float ss = 0.f;
#pragma unroll
        for (int k = 0; k < 4; ++k) { const f32x4 x0 = *(const LAS f32x4*)(OB + (size_t)q * 68 + 16 * part + 4 * k), x1 = *(const LAS f32x4*)(OB + (size_t)(128 + q) * 68 + 16 * part + 4 * k);
            const f32x4 d = x0 - x1 * lam; o[4 * k] = d.x; o[4 * k + 1] = d.y; o[4 * k + 2] = d.z; o[4 * k + 3] = d.w; ss += (d.x * d.x + d.y * d.y) + (d.z * d.z + d.w * d.w); }
        ss += shfl_f(ss, lane ^ 1); ss += shfl_f(ss, lane ^ 2);
        const float rs = rsqrtf(ss * (1.f / 64.f) + EPS) * (1.f - lam_init);
        bf16* dst = c.MIX + ((size_t)b * S + qb * 128 + q) * 1024 + 512 + h * 64 + 16 * part;
#pragma unroll
        for (int k = 0; k < 2; ++k) *(v4u*)(dst + 8 * k) = (v4u){cvt2(o[8 * k] * rs * nw[8 * k], o[8 * k + 1] * rs * nw[8 * k + 1]), cvt2(o[8 * k + 2] * rs * nw[8 * k + 2], o[8 * k + 3] * rs * nw[8 * k + 3]),
                                                                 cvt2(o[8 * k + 4] * rs * nw[8 * k + 4], o[8 * k + 5] * rs * nw[8 * k + 5]), cvt2(o[8 * k + 6] * rs * nw[8 * k + 6], o[8 * k + 7] * rs * nw[8 * k + 7])};
    }
}

__device__ __forceinline__ float attn3_tmax(AttnTile& t, lf32 RLb, int qpos, int k0, int hh, bool diag) {
    float mt;
    if (t.far) { mt = t.s[0];
#pragma unroll
        for (int i = 1; i < 16; ++i) mt = fmaxf(mt, t.s[i]);
        return mt; }
    lf32 rb = RLb + (191 - qpos + k0 + 4 * hh);
    float bias[16];
#pragma unroll
    for (int i = 0; i < 16; ++i) bias[i] = rb[(i & 3) + 8 * (i >> 2)];
    mt = -1e30f;
    if (diag) {
#pragma unroll
        for (int i = 0; i < 16; ++i) { const float v = (k0 + crow(i, hh) <= qpos) ? t.s[i] + bias[i] : -1e30f; t.s[i] = v; mt = fmaxf(mt, v); }
    } else {
#pragma unroll
        for (int i = 0; i < 16; ++i) { const float v = t.s[i] + bias[i]; t.s[i] = v; mt = fmaxf(mt, v); }
    }
    return mt;
}
__device__ __forceinline__ float attn3_probs(AttnTile& t) {
    float ps = 0.f;
#pragma unroll
    for (int i = 0; i < 16; ++i) { t.s[i] = __builtin_amdgcn_exp2f(t.s[i]); ps += t.s[i]; }
    return ps;
}
__device__ __forceinline__ void attn3_unit(const MixCtx& c, int b, int h, int qb, float lam, float lam_init, LAS unsigned char* lds, int wave, int lane) {
    constexpr float LOG2E = 1.4426950408889634f, THR = 6.0f;
    constexpr int STAGE = 18432 + 24576;
    const int tid = wave * 64 + lane;
    lf32 LUT = (lf32)lds;
    lf32 OB = (lf32)(lds + 1024);
    const int m = wave >> 2, qs = wave & 3, r = lane & 31, hh = lane >> 5;
    const int q0 = qb * 128 + qs * 32, qpos = q0 + r;
    const float cb = c.in[I_RELB][31 * 4 + h] * LOG2E;
    WG_BAR();
    if (tid < 224) { const int d = 191 - tid; LUT[tid] = c.in[I_RELB][T5_BUCKET[d < 0 ? 0 : (d < 127 ? d : 127)] * 4 + h] * LOG2E - cb; }
    bf16x8 qf[2];
    { const bf16* qp = c.PROJ + ((size_t)b * S + qpos) * PJ + O_DQ + h * 64 + m * 32 + 8 * hh; qf[0] = *(const bf16x8*)qp; qf[1] = *(const bf16x8*)(qp + 16); }
    f32x16 o0 = zero16(), o1 = zero16(), negm; float lrun = 0.f;
#pragma unroll
    for (int i = 0; i < 16; ++i) negm[i] = cb;
    const int soct = tid & 7, sr0 = tid >> 3;
    const bf16* kvbase = c.PROJ + ((size_t)b * S + sr0) * PJ + h * 64 + 8 * soct;
    v4u kreg[2], vreg[2];
#define ATT_LOAD(kb_) do { _Pragma("unroll") for (int pass = 0; pass < 2; ++pass) { const bf16* row = kvbase + (size_t)((kb_) * 128 + 64 * pass) * PJ; kreg[pass] = *(const v4u*)(row + O_DK); vreg[pass] = *(const v4u*)(row + O_DV); } } while (0)
#define ATT_STORE(buf_) do { LAS unsigned char* sb_ = lds + 1024 + (buf_) * STAGE; _Pragma("unroll") for (int pass = 0; pass < 2; ++pass) { const int key = sr0 + 64 * pass; \
        *(LAS v4u*)((lbf)sb_ + key * 72 + 8 * soct) = kreg[pass]; *(LAS v4u*)((lbf)(sb_ + 18432) + key * 96 + 8 * soct) = vreg[pass]; } } while (0)
#define ATT_QK(t_, kt_) do { lbf kp_ = KS + ((kt_) * 32 + r) * 72 + m * 32 + 8 * hh; \
        (t_).s = __builtin_amdgcn_mfma_f32_32x32x16_bf16(*(const LAS bf16x8*)kp_, qf[0], negm, 0, 0, 0); \
        (t_).s = __builtin_amdgcn_mfma_f32_32x32x16_bf16(*(const LAS bf16x8*)(kp_ + 16), qf[1], (t_).s, 0, 0, 0); } while (0)
    ATT_LOAD(0);
    ATT_STORE(0);
    if (qb > 0) ATT_LOAD(1);
    WG_BAR();
#pragma unroll 1
    for (int kb = 0; kb <= qb; ++kb) {
        lbf KS = (lbf)(lds + 1024 + (kb & 1) * STAGE), VS = (lbf)(lds + 1024 + (kb & 1) * STAGE + 18432);
        const int ntile = (kb < qb) ? 4 : qs + 1;
        int kt = 0;
#pragma unroll 1
        for (; kt + 1 < ntile; kt += 2) {
            const int k0 = kb * 128 + kt * 32;
            AttnTile ta, tb; ta.far = (q0 - k0 >= 144); tb.far = (q0 - (k0 + 32) >= 144);
            ATT_QK(ta, kt); ATT_QK(tb, kt + 1);
            const float tm = xhalf_max(fmaxf(attn3_tmax(ta, LUT, qpos, k0, hh, k0 == q0), attn3_tmax(tb, LUT, qpos, k0 + 32, hh, k0 + 32 == q0)));
            if (__any(tm > THR)) { const float d = (tm > THR) ? tm : 0.f, al = __builtin_amdgcn_exp2f(-d); lrun *= al;
#pragma unroll
                for (int i = 0; i < 16; ++i) { o0[i] *= al; o1[i] *= al; negm[i] -= d; ta.s[i] -= d; tb.s[i] -= d; } }
            lrun += attn3_probs(ta) + attn3_probs(tb);
            attn_pv(ta, VS, kt * 32, o0, o1, lane); attn_pv(tb, VS, kt * 32 + 32, o0, o1, lane);
        }
        if (kt < ntile) {
            const int k0 = kb * 128 + kt * 32;
            AttnTile ta; ta.far = (q0 - k0 >= 144);
            ATT_QK(ta, kt);
            const float tm = xhalf_max(attn3_tmax(ta, LUT, qpos, k0, hh, k0 == q0));
            if (__any(tm > THR)) { const float d = (tm > THR) ? tm : 0.f, al = __builtin_amdgcn_exp2f(-d); lrun *= al;
#pragma unroll
                for (int i = 0; i < 16; ++i) { o0[i] *= al; o1[i] *= al; negm[i] -= d; ta.s[i] -= d; } }
            lrun += attn3_probs(ta);
            attn_pv(ta, VS, kt * 32, o0, o1, lane);
        }
        if (kb < qb) {
            ATT_STORE((kb + 1) & 1);
            if (kb + 1 < qb) ATT_LOAD(kb + 2);
        }
        WG_BAR();
    }
#undef ATT_LOAD
#undef ATT_STORE
#undef ATT_QK
    lrun = xhalf_sum(lrun);
    { const float inv = 1.f / lrun; lf32 ob = OB + (size_t)(m * 128 + qs * 32 + r) * 68;
#pragma unroll
      for (int i = 0; i < 16; ++i) { ob[crow(i, hh)] = o0[i] * inv; ob[32 + crow(i, hh)] = o1[i] * inv; } }
    WG_BAR();
    {
        const int q = tid >> 2, part = tid & 3; const float* nw = c.in[I_DNW] + c.L * 64 + 16 * part;
        float o[16]; float ss = 0.f;
#pragma unroll
        for (int k = 0; k < 4; ++k) { const f32x4 x0 = *(const LAS f32x4*)(OB + (size_t)q * 68 + 16 * part + 4 * k), x1 = *(const LAS f32x4*)(OB + (size_t)(128 + q) * 68 + 16 * part + 4 * k);
            const f32x4 d = x0 - x1 * lam; o[4 * k] = d.x; o[4 * k + 1] = d.y; o[4 * k + 2] = d.z; o[4 * k + 3] = d.w; ss += (d.x * d.x + d.y * d.y) + (d.z * d.z + d.w * d.w); }
        ss += shfl_f(ss, lane ^ 1); ss += shfl_f(ss, lane ^ 2);
        const float rs = rsqrtf(ss * (1.f / 64.f) + EPS) * (1.f - lam_init);
        bf16* dst = c.MIX + ((size_t)b * S + qb * 128 + q) * 1024 + 512 + h * 64 + 16 * part;
#pragma unroll
        for (int k = 0; k < 2; ++k) *(v4u*)(dst + 8 * k) = (v4u){cvt2(o[8 * k] * rs * nw[8 * k], o[8 * k + 1] * rs * nw[8 * k + 1]), cvt2(o[8 * k + 2] * rs * nw[8 * k + 2], o[8 * k + 3] * rs * nw[8 * k + 3]),
                                                                 cvt2(o[8 * k + 4] * rs * nw[8 * k + 4], o[8 * k + 5] * rs * nw[8 * k + 5]), cvt2(o[8 * k + 6] * rs * nw[8 * k + 6], o[8 * k + 7] * rs * nw[8 * k + 7])};
    }
}

__device__ __forceinline__ void ml_out2_unit(const MixCtx& c, int up, LAS unsigned char* lds, int wave, int lane) {
    const int half = wave >> 2, li = wave & 3, u = 2 * up + half, h = u & 3, bc = u >> 2, t0 = bc * 128;
    const int ht = (wave & 3) * 64 + lane;
    const int r = lane & 31, hh = lane >> 5, l = 32 * li + r;
    LAS unsigned char* hb = lds + half * 73216;
    lf32 RM = (lf32)hb, U = (lf32)(hb + 512), MT = (lf32)(hb + 1024), WI = (lf32)(hb + 1536), NP = (lf32)(hb + 2048);
    lbf Q = (lbf)(hb + 2560), Kk = (lbf)(hb + 2560 + 18432), VS = (lbf)(hb + 2560 + 2 * 18432), CP = (lbf)(hb + 2560 + 2 * 18432 + 24576);
    lbf OT = Q;
    const unsigned char* ms = c.ws + WS_MISC;
    WG_BAR();
    v4u oraw[4];
#pragma unroll
    for (int k = 0; k < 4; ++k) { const int e = ht + 256 * k; oraw[k] = *(const v4u*)(c.PROJ + (size_t)(t0 + (e >> 3)) * PJ + O_MO + h * 64 + 8 * (e & 7)); }
    {
#pragma unroll
        for (int k = 0; k < 4; ++k) { const int e = ht + 256 * k, s = e >> 3, oct = e & 7; const bf16* row = c.PROJ + (size_t)(t0 + s) * PJ + h * 64 + 8 * oct;
            *(LAS v4u*)(Q + s * 72 + 8 * oct) = *(const v4u*)(row + O_MQ);
            float kv[8]; unpack8(*(const v4u*)(row + O_MK), kv);
#pragma unroll
            for (int q = 0; q < 8; ++q) kv[q] *= 0.125f;
            *(LAS v4u*)(Kk + s * 72 + 8 * oct) = pack8(kv);
            *(LAS v4u*)(VS + s * 96 + 8 * oct) = *(const v4u*)(row + O_MV); }
#pragma unroll
        for (int k = 0; k < 2; ++k) { const int e = ht + 256 * k; *(LAS v4u*)(CP + (e >> 3) * 72 + 8 * (e & 7)) = ((const v4u*)(c.cprev + (size_t)u * 4096))[e]; }
    }
    if (li == 0) {
        const float ib = c.in[I_MIB][c.L * 4 + h], fb = c.in[I_MFB][c.L * 4 + h];
        const float li0 = c.SMALL[(size_t)(t0 + 2 * lane) * 16 + SM_MI + h] + ib, li1 = c.SMALL[(size_t)(t0 + 2 * lane + 1) * 16 + SM_MI + h] + ib;
        float b0 = logsigmoid_fast(c.SMALL[(size_t)(t0 + 2 * lane) * 16 + SM_MF + h] + fb), b1 = logsigmoid_fast(c.SMALL[(size_t)(t0 + 2 * lane + 1) * 16 + SM_MF + h] + fb);
        scan_add128(b0, b1, lane);
        const float u0 = li0 - b0, u1 = li1 - b1; float p0 = u0, p1 = u1; scan_max128(p0, p1, lane);
        const float mp = ((const float*)(ms + MS_MP))[u];
        const float in0 = b0 + mp, in1 = b1 + mp, mt0 = fmaxf(in0, b0 + p0), mt1 = fmaxf(in1, b1 + p1);
        U[2 * lane] = u0; U[2 * lane + 1] = u1; RM[2 * lane] = b0 - mt0; RM[2 * lane + 1] = b1 - mt1; MT[2 * lane] = mt0; MT[2 * lane + 1] = mt1;
        WI[2 * lane] = __expf(in0 - mt0); WI[2 * lane + 1] = __expf(in1 - mt1);
        NP[lane] = ((const float*)(ms + MS_NL))[(size_t)u * 64 + lane];
    }
    WG_BAR();
    const float rml = RM[l], wil = WI[l];
    f32x16 a0 = zero16(), a1 = zero16();
    mma<false, false>(a0, CP, 72, 0, Q, 72, 32 * li, 64, lane);
    mma<false, false>(a1, CP, 72, 32, Q, 72, 32 * li, 64, lane);
#pragma unroll
    for (int i = 0; i < 16; ++i) { a0[i] *= wil; a1[i] *= wil; }
    float den = 0.f;
    {
#pragma unroll
        for (int k = 0; k < 4; ++k) { float qv[8]; unpack8(*(const LAS v4u*)(Q + l * 72 + 32 * hh + 8 * k), qv);
#pragma unroll
            for (int q = 0; q < 8; ++q) den += qv[q] * NP[32 * hh + 8 * k + q]; }
        den *= wil;
    }
#pragma unroll 1
    for (int si = 0; si <= li; ++si) {
        f32x16 st = zero16();
        mma<false, false>(st, Kk, 72, 32 * si, Q, 72, 32 * li, 64, lane);
        float us[16];
#pragma unroll
        for (int i = 0; i < 16; ++i) us[i] = U[32 * si + crow(i, hh)];
#pragma unroll
        for (int i = 0; i < 16; ++i) { const int s2 = 32 * si + crow(i, hh); const float w = st[i] * __expf(fminf(rml + us[i], 0.f)); st[i] = (si < li || s2 <= l) ? w : 0.f; den += st[i]; }
#pragma unroll
        for (int s2 = 0; s2 < 2; ++s2) {
            const v4u pw = {cvt2(st[8 * s2], st[8 * s2 + 1]), cvt2(st[8 * s2 + 2], st[8 * s2 + 3]), cvt2(st[8 * s2 + 4], st[8 * s2 + 5]), cvt2(st[8 * s2 + 6], st[8 * s2 + 7])};
            const bf16x8 pf = __builtin_bit_cast(bf16x8, pw);
            a0 = __builtin_amdgcn_mfma_f32_32x32x16_bf16(frag_tp(VS, 96, 32 * si + 16 * s2, 0, lane), pf, a0, 0, 0, 0);
            a1 = __builtin_amdgcn_mfma_f32_32x32x16_bf16(frag_tp(VS, 96, 32 * si + 16 * s2, 32, lane), pf, a1, 0, 0, 0);
        }
    }
    den = xhalf_sum(den);
    const float inv = 1.f / fmaxf(fabsf(den), __expf(-MT[l]));
    float ss = 0.f;
#pragma unroll
    for (int i = 0; i < 16; ++i) { a0[i] *= inv; a1[i] *= inv; ss += a0[i] * a0[i] + a1[i] * a1[i]; }
    ss = xhalf_sum(ss);
    const float rs = rsqrtf(ss * (1.f / 64.f) + EPS);
    WG_BAR();
    {
        const float* nw = c.in[I_MNW] + c.L * 256 + h * 64;
        lbf orow = OT + l * 72 + 4 * hh;
#pragma unroll
        for (int g = 0; g < 4; ++g) { const f32x4 w0 = *(const f32x4*)(nw + 8 * g + 4 * hh), w1 = *(const f32x4*)(nw + 32 + 8 * g + 4 * hh);
            *(LAS u32x2m*)(orow + 8 * g) = (u32x2m){cvt2(a0[4 * g] * rs * w0.x, a0[4 * g + 1] * rs * w0.y), cvt2(a0[4 * g + 2] * rs * w0.z, a0[4 * g + 3] * rs * w0.w)};
            *(LAS u32x2m*)(orow + 32 + 8 * g) = (u32x2m){cvt2(a1[4 * g] * rs * w1.x, a1[4 * g + 1] * rs * w1.y), cvt2(a1[4 * g + 2] * rs * w1.z, a1[4 * g + 3] * rs * w1.w)}; }
    }
    WG_BAR();
#pragma unroll
    for (int k = 0; k < 4; ++k) { const int e = ht + 256 * k, row = e >> 3, piece = e & 7;
        float hv[8], ov[8]; unpack8(*(const LAS v4u*)(OT + row * 72 + 8 * piece), hv); unpack8(oraw[k], ov);
#pragma unroll
        for (int q = 0; q < 8; ++q) hv[q] *= __builtin_amdgcn_rcpf(1.0f + __expf(-ov[q]));
        *(v4u*)(c.MIX + (size_t)(t0 + row) * 1024 + 768 + h * 64 + 8 * piece) = pack8(hv); }
}
}
constexpr int CW_BAR = 4096;
constexpr int N_BAR_REGIONS = 4;
static_assert((CW_BAR + N_BAR_REGIONS * XCD_BAR_WORDS) * 4 <= (int)CTL_ZERO_BYTES, "CTL words inside the memset region");
constexpr int RING_OFF = 0, RING_BYTES = 131072, PHASE_BYTES = 147456;
constexpr int LDSCTL_OFF = PHASE_BYTES, MISC_OFF = LDSCTL_OFF + 320;
constexpr int LDS_BYTES = PHASE_BYTES + 1024;
static_assert(MISC_OFF + 128 <= LDS_BYTES, "LDS map");
#define LDS_WAIT() asm volatile("s_waitcnt lgkmcnt(0)" ::: "memory")

struct Frame {
    LAS unsigned char* lds;
    volatile LAS unsigned* MISC;
    unsigned* ctl;
    int wave, G;
};
#define LANE() lane_id_asm()

__device__ __forceinline__ unsigned pk2(float lo, float hi) { return (unsigned)f2bf(lo) | ((unsigned)f2bf(hi) << 16); }
template <class RM>
__device__ __forceinline__ void transpose_item(const float* W, int K, int N, bf16* WT, RM rowmap, const float* kscale, LAS float* scr, int item, int lane) {
    const int nblk = (N + 31) / 32, kb = item / nblk, nb = item % nblk, k0 = 64 * kb, n0 = 32 * nb;
    const bool nok = (n0 + (lane & 31)) < N;
    float wv_[32];
    const int ncol = nok ? n0 + (lane & 31) : N - 1;
#pragma unroll
    for (int i = 0; i < 32; ++i) { const int kk = 2 * i + (lane >> 5); wv_[i] = W[(size_t)(k0 + kk) * N + ncol]; }
#pragma unroll
    for (int i = 0; i < 32; ++i) { const int kk = 2 * i + (lane >> 5); float v = wv_[i]; if (kscale) v *= kscale[k0 + kk]; scr[kk * 33 + (lane & 31)] = v; }
    LDS_WAIT(); asm volatile("" ::: "memory");
    const int c = lane & 7;
#pragma unroll
    for (int j = 0; j < 4; ++j) { const int n = (lane >> 3) + 8 * j; const LAS float* s = scr + (8 * c) * 33 + n;
        v4u o; o.x = pk2(s[0 * 33], s[1 * 33]); o.y = pk2(s[2 * 33], s[3 * 33]); o.z = pk2(s[4 * 33], s[5 * 33]); o.w = pk2(s[6 * 33], s[7 * 33]);
        if (n0 + n < N) *(v4u*)(WT + (size_t)rowmap(n0 + n) * K + k0 + 8 * c) = o; }
    LDS_WAIT(); asm volatile("" ::: "memory");
}
__device__ __forceinline__ int rowmap_win(int c) { return c < 1536 ? c : (c < 1544 ? 3328 + (c - 1536) : (c < 3336 ? c - 8 : 3328 + 8 + (c - 3336))); }

__device__ __forceinline__ void p0_prologue(Frame& F, const Args& a) {
    unsigned char* ws = a.ws;
    LAS float* scr = (LAS float*)(F.lds + RING_OFF + F.wave * 16384);
    const int lane = LANE(), tid = F.wave * 64 + lane;
    const int gw = blockIdx.x * NWAVES + F.wave, NGW = F.G * NWAVES;
    constexpr int I_IN = 16 * 105, I_SQ = 16 * 32, I_GU = 16 * 88, I_DN = 44 * 32, I_PPJ = 4 * 32;
    constexpr int PER_LAYER = I_IN + I_SQ + 2 * I_GU + I_DN + I_SQ + I_PPJ;
    for (int it = gw; it < DEPTH * PER_LAYER; it += NGW) {
        const int L = it / PER_LAYER; int r = it % PER_LAYER;
        unsigned char* wl = ws + WS_W + (size_t)L * W_LAYER;
        if (r < I_IN) { transpose_item(a.in[I_WIN] + (size_t)L * D * INC, D, INC, (bf16*)(wl + W_IN), [](int c) { return rowmap_win(c); }, a.in[I_N1W] + L * D, scr, r, lane); continue; } r -= I_IN;
        if (r < I_SQ) { transpose_item(a.in[I_WOUT] + (size_t)L * D * D, D, D, (bf16*)(wl + W_OUT), [](int c) { return c; }, nullptr, scr, r, lane); continue; } r -= I_SQ;
        if (r < I_GU) { transpose_item(a.in[I_WG] + (size_t)L * D * FF, D, FF, (bf16*)(wl + W_GU), [](int c) { return 256 * (c >> 7) + (c & 127); }, a.in[I_N2W] + L * D, scr, r, lane); continue; } r -= I_GU;
        if (r < I_GU) { transpose_item(a.in[I_WU] + (size_t)L * D * FF, D, FF, (bf16*)(wl + W_GU), [](int c) { return 256 * (c >> 7) + 128 + (c & 127); }, a.in[I_N2W] + L * D, scr, r, lane); continue; } r -= I_GU;
        if (r < I_DN) { transpose_item(a.in[I_WD] + (size_t)L * FF * D, FF, D, (bf16*)(wl + W_DN), [](int c) { return c; }, nullptr, scr, r, lane); continue; } r -= I_DN;
        if (r < I_SQ) { transpose_item(a.in[I_PGW] + (size_t)L * D * D, D, D, (bf16*)(wl + W_PG), [](int c) { return c; }, nullptr, scr, r, lane); continue; } r -= I_SQ;
        transpose_item(a.in[I_PPW] + (size_t)L * PLE * D, PLE, D, (bf16*)(wl + W_PP), [](int c) { return c; }, nullptr, scr, r, lane);
    }
    {
        const int gt = blockIdx.x * NT + tid, ngt = F.G * NT; constexpr int PER = (NPROJ - INC) * D / 8;
        for (int e = gt; e < DEPTH * PER; e += ngt) { const int L = e / PER, r = e % PER;
            *(v4u*)((bf16*)(ws + WS_W + (size_t)L * W_LAYER + W_IN) + (size_t)INC * D + (size_t)r * 8) = (v4u){0u, 0u, 0u, 0u}; }
    }
    {
        const float* x = a.in[I_X]; bf16* hb2 = (bf16*)(ws + WS_HB2); float* ssqp = (float*)(ws + WS_SSQP);
        for (int m = gw; m < M; m += 2 * NGW) {
            const int m2 = (m + NGW < M) ? m + NGW : m;
            const f32x4* xa = (const f32x4*)(x + (size_t)m * D) + lane; const f32x4* xb = (const f32x4*)(x + (size_t)m2 * D) + lane;
            f32x4 va[4], vb[4];
#pragma unroll
            for (int j = 0; j < 4; ++j) { va[j] = xa[64 * j]; vb[j] = xb[64 * j]; }
            unsigned long long* oa = (unsigned long long*)(hb2 + (size_t)m * D) + lane; unsigned long long* ob = (unsigned long long*)(hb2 + (size_t)m2 * D) + lane; float sa = 0.f, sb = 0.f;
#pragma unroll
            for (int j = 0; j < 4; ++j) { sa += (va[j].x * va[j].x + va[j].y * va[j].y) + (va[j].z * va[j].z + va[j].w * va[j].w); sb += (vb[j].x * vb[j].x + vb[j].y * vb[j].y) + (vb[j].z * vb[j].z + vb[j].w * vb[j].w);
                oa[64 * j] = (unsigned long long)pk2(va[j].x, va[j].y) | ((unsigned long long)pk2(va[j].z, va[j].w) << 32); ob[64 * j] = (unsigned long long)pk2(vb[j].x, vb[j].y) | ((unsigned long long)pk2(vb[j].z, vb[j].w) << 32); }
            sa = wave_sum_l(sa, lane); sb = wave_sum_l(sb, lane);
            if (lane < 16) { ssqp[(size_t)m * 16 + lane] = (lane == 0) ? sa : 0.f; ssqp[(size_t)m2 * 16 + lane] = (lane == 0) ? sb : 0.f; }
        }
    }
    {
        const float* p = a.in[I_P]; bf16* pb = (bf16*)(ws + WS_PB);
        const size_t gt = (size_t)blockIdx.x * NT + tid, ngt = (size_t)F.G * NT, n8 = (size_t)DEPTH * M * PLE / 8;
        for (size_t e = gt; e < n8; e += 4 * ngt) {
            f32x4 v0[4], v1[4];
#pragma unroll
            for (int k = 0; k < 4; ++k) { const size_t ek = (e + k * ngt < n8) ? e + k * ngt : e; v0[k] = *(const f32x4*)(p + ek * 8); v1[k] = *(const f32x4*)(p + ek * 8 + 4); }
#pragma unroll
            for (int k = 0; k < 4; ++k) if (e + k * ngt < n8) *(v4u*)(pb + (e + k * ngt) * 8) = (v4u){pk2(v0[k].x, v0[k].y), pk2(v0[k].z, v0[k].w), pk2(v1[k].x, v1[k].y), pk2(v1[k].z, v1[k].w)};
        }
    }
}

constexpr int NTN = 256;
template <int PH> __global__ void __launch_bounds__(NTN, 1) naive_mix(Args a, int L) {
    extern __shared__ __attribute__((aligned(16))) unsigned char lds_raw[];
    float* ldsf = (float*)lds_raw;
    const int tid = threadIdx.x, lane = tid & 63, wave = tid >> 6;
    const int gtid = blockIdx.x * NTN + tid, gthreads = gridDim.x * NTN;
    const int gw = blockIdx.x * (NTN / 64) + wave, ngw = gridDim.x * (NTN / 64);
    unsigned char* ws = a.ws;
    const bf16* PROJ = (const bf16*)(ws + WS_PROJ); const float* SMALL = (const float*)(ws + WS_SMALL);
    bf16* XC = (bf16*)(ws + WS_XC); bf16* MIX = (bf16*)(ws + WS_MIX);
    if constexpr (PH == 2) {
        const float* cw = a.in[I_CONVW] + L * 4 * 1024; const float* cb = a.in[I_CONVB] + L * 1024;
        for (size_t e = gtid; e < (size_t)M * 1024; e += gthreads) {
            const int ch = (int)(e & 1023), t = (int)(e >> 10), s = t & (S - 1);
            float acc = cb[ch];
#pragma unroll
            for (int k = 0; k < 4; ++k) { const int ss = s - 3 + k; if (ss >= 0) acc += cw[k * 1024 + ch] * bf2f(PROJ[(size_t)(t - 3 + k) * PJ + O_XBC + ch]); }
            XC[e] = f2bf(siluf_(acc));
        }
    }
    if constexpr (PH == 3) {
        for (int u = gw; u < NB * 8; u += ngw) {
            const int b = u >> 3, hd = u & 7, g = hd >> 2;
            const float dtb = a.in[I_DTB][L * 8 + hd], A = -expf(a.in[I_ALOG][L * 8 + hd]), Dsk = a.in[I_SSDD][L * 8 + hd];
            float st[128];
#pragma unroll
            for (int n = 0; n < 128; ++n) st[n] = 0.f;
            for (int s = 0; s < S; ++s) {
                const size_t t = (size_t)b * S + s;
                const float dt = softplusf_(SMALL[t * 16 + SM_DT + hd] + dtb), dA = expf(dt * A);
                const float x = bf2f(XC[t * 1024 + hd * 64 + lane]), xdt = x * dt;
                const v4u* Bp = (const v4u*)(XC + t * 1024 + 512 + g * 128); const v4u* Cp = (const v4u*)(XC + t * 1024 + 768 + g * 128);
                float y = 0.f;
#pragma unroll
                for (int n8 = 0; n8 < 16; ++n8) { const v4u bw = Bp[n8], cw = Cp[n8];
#pragma unroll
                    for (int j = 0; j < 4; ++j) { const unsigned bu = bw[j], cu = cw[j]; const int n = 8 * n8 + 2 * j;
                        st[n] = st[n] * dA + __uint_as_float(bu << 16) * xdt; y += __uint_as_float(cu << 16) * st[n];
                        st[n + 1] = st[n + 1] * dA + __uint_as_float(bu & 0xffff0000u) * xdt; y += __uint_as_float(cu & 0xffff0000u) * st[n + 1]; } }
                MIX[t * 1024 + hd * 64 + lane] = f2bf(y + x * Dsk);
            }
        }
    }
    if constexpr (PH == 4) {
        const float* nw = a.in[I_SSDNW] + L * 512;
        for (int m = gw; m < M; m += ngw) {
            float gv[8]; float s = 0.f;
#pragma unroll
            for (int j = 0; j < 8; ++j) { const int c = lane * 8 + j; const float z = bf2f(PROJ[(size_t)m * PJ + O_Z + c]); gv[j] = bf2f(MIX[(size_t)m * 1024 + c]) * siluf_(z); s += gv[j] * gv[j]; }
            const float r = rsqrtf(wave_sum(s) * (1.f / 512.f) + EPS);
#pragma unroll
            for (int j = 0; j < 8; ++j) { const int c = lane * 8 + j; MIX[(size_t)m * 1024 + c] = f2bf(gv[j] * r * nw[c]); }
        }
    }
    if constexpr (PH == 5) {
        float* lut = ldsf;
        const float lam_init = 0.8f - 0.6f * expf(-0.3f * (float)L);
        float d1 = 0.f, d2 = 0.f;
        for (int i = 0; i < 32; ++i) { d1 += a.in[I_LQ1][L * 32 + i] * a.in[I_LK1][L * 32 + i]; d2 += a.in[I_LQ2][L * 32 + i] * a.in[I_LK2][L * 32 + i]; }
        const float lam = expf(d1) - expf(d2) + lam_init;
        const float* dnw = a.in[I_DNW] + L * 64;
        for (int vb = blockIdx.x; vb < M * 4 / NTN; vb += gridDim.x) {
            const int gid = vb * NTN + tid, q = gid & (S - 1), h = (gid >> 11) & 3, b = gid >> 13;
            __syncthreads();
            if (tid < 128) lut[tid] = a.in[I_RELB][T5_BUCKET[tid] * 4 + h];
            __syncthreads();
            const size_t t = (size_t)b * S + q;
            float q0[32], q1[32];
            const float sc = 0.17677669529663687f;
#pragma unroll
            for (int d = 0; d < 32; ++d) { q0[d] = bf2f(PROJ[t * PJ + O_DQ + h * 64 + d]) * sc; q1[d] = bf2f(PROJ[t * PJ + O_DQ + h * 64 + 32 + d]) * sc; }
            float m0 = -1e30f, l0 = 0.f, m1 = -1e30f, l1 = 0.f;
            const int kend = q | 63;
            for (int k = 0; k <= kend; ++k) {
                const bf16* kp = PROJ + ((size_t)b * S + k) * PJ + O_DK + h * 64;
                float s0 = 0.f, s1 = 0.f;
#pragma unroll
                for (int d = 0; d < 32; ++d) { s0 += q0[d] * bf2f(kp[d]); s1 += q1[d] * bf2f(kp[32 + d]); }
                if (k <= q) {
                    const int dist = q - k; const float bias = lut[dist < 127 ? dist : 127];
                    s0 += bias; s1 += bias;
                    if (s0 > m0) { l0 = l0 * __expf(m0 - s0) + 1.f; m0 = s0; } else l0 += __expf(s0 - m0);
                    if (s1 > m1) { l1 = l1 * __expf(m1 - s1) + 1.f; m1 = s1; } else l1 += __expf(s1 - m1);
                }
            }
            float o[64];
#pragma unroll
            for (int e = 0; e < 64; ++e) o[e] = 0.f;
            const float il0 = 1.f / l0, il1 = lam / l1;
            for (int k = 0; k <= kend; ++k) {
                const bf16* kp = PROJ + ((size_t)b * S + k) * PJ + O_DK + h * 64;
                const bf16* vp = PROJ + ((size_t)b * S + k) * PJ + O_DV + h * 64;
                float s0 = 0.f, s1 = 0.f;
#pragma unroll
                for (int d = 0; d < 32; ++d) { s0 += q0[d] * bf2f(kp[d]); s1 += q1[d] * bf2f(kp[32 + d]); }
                float w = 0.f;
                if (k <= q) { const int dist = q - k; const float bias = lut[dist < 127 ? dist : 127]; w = __expf(s0 + bias - m0) * il0 - __expf(s1 + bias - m1) * il1; }
#pragma unroll
                for (int e = 0; e < 64; ++e) o[e] += w * bf2f(vp[e]);
            }
            float ss = 0.f;
#pragma unroll
            for (int e = 0; e < 64; ++e) ss += o[e] * o[e];
            const float r = rsqrtf(ss * (1.f / 64.f) + EPS) * (1.f - lam_init);
#pragma unroll
            for (int e = 0; e < 64; ++e) MIX[t * 1024 + 512 + h * 64 + e] = f2bf(o[e] * r * dnw[e]);
        }
    }
    if constexpr (PH == 6) {
        for (int u = gw; u < NB * 4; u += ngw) {
            const int b = u >> 2, h = u & 3;
            const float ib = a.in[I_MIB][L * 4 + h], fb = a.in[I_MFB][L * 4 + h], nwe = a.in[I_MNW][L * 256 + h * 64 + lane];
            float C[64], nv[64];
#pragma unroll
            for (int d = 0; d < 64; ++d) { C[d] = 0.f; nv[d] = 0.f; }
            float mprev = 0.f;
            for (int s = 0; s < S; ++s) {
                const size_t t = (size_t)b * S + s; const bf16* row = PROJ + t * PJ;
                const float logi = SMALL[t * 16 + SM_MI + h] + ib, logf_ = logsigmoidf_(SMALL[t * 16 + SM_MF + h] + fb);
                const float mnew = fmaxf(logf_ + mprev, logi), fa = expf(logf_ + mprev - mnew), ia = expf(logi - mnew);
                const float ve = bf2f(row[O_MV + h * 64 + lane]) * ia;
                float num = 0.f, den = 0.f;
#pragma unroll
                for (int d = 0; d < 64; ++d) {
                    const float kd = bf2f(row[O_MK + h * 64 + d]) * 0.125f, qd = bf2f(row[O_MQ + h * 64 + d]);
                    C[d] = C[d] * fa + ve * kd; nv[d] = nv[d] * fa + ia * kd; num += C[d] * qd; den += nv[d] * qd;
                }
                const float hv = num / fmaxf(fabsf(den), expf(-mnew));
                const float r = rsqrtf(wave_sum(hv * hv) * (1.f / 64.f) + EPS);
                MIX[t * 1024 + 768 + h * 64 + lane] = f2bf(sigmoidf_(bf2f(row[O_MO + h * 64 + lane])) * hv * r * nwe);
                mprev = mnew;
            }
        }
    }
}

__device__ __forceinline__ void fill_rstd_table(const pg8::StaticOrder& So, const float* ssqp, LAS float* rtab, int wave, int lane) {
    const int tid = wave * 64 + lane;
    for (int i = tid >> 8; ; i += 2) { pg8::Unit u; if (!So.next(i, u)) break;
        const f32x4* p = (const f32x4*)(ssqp + (size_t)(u.pm * 256 + (tid & 255)) * 16);
        const f32x4 a = p[0], b = p[1], c = p[2], d = p[3];
        const float s = (((a.x + a.y) + (a.z + a.w)) + ((b.x + b.y) + (b.z + b.w))) + (((c.x + c.y) + (c.z + c.w)) + ((d.x + d.y) + (d.z + d.w)));
        rtab[i * 256 + (tid & 255)] = rsqrtf(s * (1.0f / 1024.0f) + EPS); }
    __syncthreads();
}

#ifndef SMALL_WGM
#define SMALL_WGM 4
#endif
constexpr int PH_FINAL = 1 + 8 * DEPTH, PH_END = PH_FINAL + 1;
__global__ void __launch_bounds__(NT, 2) mk_fwd(Args a) {
    extern __shared__ __attribute__((aligned(16))) unsigned char lds[];
    Frame F;
    F.lds = (LAS unsigned char*)lds;
    F.MISC = (volatile LAS unsigned*)(F.lds + MISC_OFF);
    F.wave = __builtin_amdgcn_readfirstlane(threadIdx.x >> 6);
    F.G = gridDim.x;
    unsigned char* ws = a.ws;
    F.ctl = (unsigned*)(ws + WS_CTL);
    for (int u = F.wave * 64 + LANE(); u < (LDS_BYTES - LDSCTL_OFF) / 4; u += NT) ((LAS unsigned*)(F.lds + LDSCTL_OFF))[u] = 0u;
    __syncthreads();
    XcdBarrier bar = xcd_barrier_post(F.ctl + CW_BAR + a.li * XCD_BAR_WORDS, F.MISC + 8, F.wave);
    const int lo = a.ph_lo, hi = a.ph_hi;
#define IN(k) (lo <= (k) && (k) < hi)
#define SEAM(k) do { if (IN(k) && IN((k) + 1)) xcd_barrier(bar); } while (0)
#ifndef DUP_MASK
#define DUP_MASK 0
#endif
#define DUP(kk) (((DUP_MASK) >> (kk)) & 1)
#ifndef DUP_PARTS
#define DUP_PARTS 7
#endif
    float* H = a.out;
    float* SSQP = (float*)(ws + WS_SSQP); float* SMALL = (float*)(ws + WS_SMALL);
    pg8::bf16_t* HB = (pg8::bf16_t*)(ws + WS_HB); pg8::bf16_t* HB2 = (pg8::bf16_t*)(ws + WS_HB2);
    pg8::bf16_t* PROJ = (pg8::bf16_t*)(ws + WS_PROJ); pg8::bf16_t* HID = (pg8::bf16_t*)(ws + WS_HID);
    pg8::bf16_t* MIX = (pg8::bf16_t*)(ws + WS_MIX); pg8::bf16_t* PP = (pg8::bf16_t*)(ws + WS_PP);

    if (IN(0)) { p0_prologue(F, a); }
#if DUP(8)
    if (IN(0)) { xcd_barrier(bar); p0_prologue(F, a); }
#endif
    SEAM(0);

    for (int L = 0; L < DEPTH; ++L) {
        const int P0 = 1 + 8 * L;
        const unsigned char* wl = ws + WS_W + (size_t)L * W_LAYER;
#define BODY_G1 \
            pg8::Gemm g{HB2, (const pg8::bf16_t*)(wl + W_IN), M, NPROJ, D}; pg8::StaticOrder So; So.init(M, NPROJ, F.G, (int)blockIdx.x); \
            fill_rstd_table(So, SSQP, (LAS float*)(F.lds + RING_BYTES), F.wave, LANE()); \
            pg8::EpiProj E{PROJ, SMALL, (const LAS float*)(F.lds + RING_BYTES)}; \
            pg8::gemm_phase<pg8::EpiProj, pg8::StaticOrder, true, true>(F.wave, F.lds + RING_OFF, g, So, E); \

        if (IN(P0 + 0)) { BODY_G1 }
#if DUP(0)
        if (IN(P0 + 0)) { xcd_barrier(bar); BODY_G1 }
#endif
        SEAM(P0 + 0);
        const mx::MixCtx mc{(const bf16*)PROJ, SMALL, (bf16*)MIX, ws, a.in, L, H, H + (size_t)16 * 1024 * 1024, (bf16*)(H + (size_t)20 * 1024 * 1024), (bf16*)(H + (size_t)28 * 1024 * 1024)};
#define BODY_A \
            const float lam_init = __int_as_float(__builtin_amdgcn_readfirstlane(__float_as_int(0.8f - 0.6f * __expf(-0.3f * (float)L)))); \
            float d1 = 0.f, d2 = 0.f; \
            for (int i = 0; i < 32; ++i) { d1 += a.in[I_LQ1][L * 32 + i] * a.in[I_LK1][L * 32 + i]; d2 += a.in[I_LQ2][L * 32 + i] * a.in[I_LK2][L * 32 + i]; } \
            const float lam_v = __expf(d1) - __expf(d2) + lam_init; \
            const float lam = __int_as_float(__builtin_amdgcn_readfirstlane(__float_as_int(lam_v))); \
            for (int u = blockIdx.x; u < 2048; u += F.G) { \
                const int lane = LANE(); \
                if (u < 512) { if (PARTS & 1) {   \
                    const int x_ = u & 7, t_ = (u >> 3) & 63, bh = (F.G == 256) ? x_ + 8 * (t_ >> 3) : u >> 3, j = (F.G == 256) ? (t_ & 7) : (u & 7); \
                    mx::attn3_unit(mc, bh >> 2, bh & 3, 15 - j, lam, lam_init, F.lds, F.wave, lane); mx::attn3_unit(mc, bh >> 2, bh & 3, j, lam, lam_init, F.lds, F.wave, lane); } } \
                else if (u < 1024) { if (PARTS & 2) mx::ssd_states_unit(mc, u - 512, F.lds, F.wave, lane); } \
                else { if (PARTS & 4) mx::ml_summary_unit(mc, u - 1024, F.lds, F.wave, lane); } \
            } \

#define PARTS 7
        if (IN(P0 + 1)) { BODY_A }
#undef PARTS
#define PARTS DUP_PARTS
#if DUP(1)
        if (IN(P0 + 1)) { xcd_barrier(bar); BODY_A }
#endif
#undef PARTS
        SEAM(P0 + 1);
        if (IN(P0 + 2)) mx::scan_phase(mc, F.G, F.wave, LANE());
#if DUP(2)
#define PARTS 6
        if (IN(P0 + 2)) { xcd_barrier(bar); { BODY_A } xcd_barrier(bar); mx::scan_phase(mc, F.G, F.wave, LANE()); }
#undef PARTS
#endif
        SEAM(P0 + 2);
#define BODY_C \
            for (int u = blockIdx.x; u < 768; u += F.G) { \
                const int lane = LANE(); \
                if (u < 256) { if (PARTS & 1) mx::ssd_out_unit(mc, u, F.lds, F.wave, lane); } \
                else { if (PARTS & 2) mx::ml_out2_unit(mc, u - 256, F.lds, F.wave, lane); } \
            } \

#ifdef SSD_PROBE_VAR
        if (IN(P0 + 3)) { for (int u = blockIdx.x; u < 256; u += F.G) mx::ssd_out_unit<SSD_PROBE_VAR>(mc, u, F.lds, F.wave, LANE()); xcd_barrier(bar); }
#endif
#define PARTS 7
        if (IN(P0 + 3)) { BODY_C }
#undef PARTS
#define PARTS DUP_PARTS
#if DUP(3)
        if (IN(P0 + 3)) { xcd_barrier(bar); BODY_C }
#endif
#undef PARTS
        SEAM(P0 + 3);
        if (IN(P0 + 4)) {
            pg8::Gemm g{MIX, (const pg8::bf16_t*)(wl + W_OUT), M, D, D}; pg8::StaticOrder So; So.init(M, D, F.G, (int)blockIdx.x, SMALL_WGM);
            if (L == 0) { pg8::EpiRes<0, true> E{a.in[I_X], HB, SSQP, nullptr};
                pg8::gemm_phase<pg8::EpiRes<0, true>, pg8::StaticOrder, true, true>(F.wave, F.lds + RING_OFF, g, So, E); }
            else { pg8::EpiRes<0, false> E{HB2, HB, SSQP, nullptr};
                pg8::gemm_phase<pg8::EpiRes<0, false>, pg8::StaticOrder, true, true>(F.wave, F.lds + RING_OFF, g, So, E); }
        }
        SEAM(P0 + 4);
#define BODY_G3 \
            pg8::Gemm g{HB, (const pg8::bf16_t*)(wl + W_GU), M, 2 * FF, D}; pg8::StaticOrder So; So.init(M, 2 * FF, F.G, (int)blockIdx.x); \
            fill_rstd_table(So, SSQP, (LAS float*)(F.lds + RING_BYTES), F.wave, LANE()); \
            pg8::EpiGateUp E{HID, (const LAS float*)(F.lds + RING_BYTES)}; \
            pg8::gemm_phase<pg8::EpiGateUp, pg8::StaticOrder, true, true>(F.wave, F.lds + RING_OFF, g, So, E); \

        if (IN(P0 + 5)) { BODY_G3 }
#if DUP(5)
        if (IN(P0 + 5)) { xcd_barrier(bar); BODY_G3 }
#endif
        SEAM(P0 + 5);
        if (IN(P0 + 6)) {
            { pg8::Gemm g{HID, (const pg8::bf16_t*)(wl + W_DN), M, D, FF}; pg8::StaticOrder So; So.init(M, D, F.G, (int)blockIdx.x, SMALL_WGM);
              pg8::EpiRes<1, false> E{HB, HB, nullptr, nullptr};
              pg8::gemm_phase<pg8::EpiRes<1, false>, pg8::StaticOrder, true, true>(F.wave, F.lds + RING_OFF, g, So, E); }
            { pg8::Gemm g{(const pg8::bf16_t*)(ws + WS_PB) + (size_t)L * M * PLE, (const pg8::bf16_t*)(wl + W_PP), M, D, PLE}; pg8::StaticOrder So; So.init(M, D, F.G, (int)blockIdx.x, SMALL_WGM);
              pg8::EpiBf16<0> E{PP, D, nullptr, 0, 0, 1.f};
              pg8::gemm_phase<pg8::EpiBf16<0>, pg8::StaticOrder, true, true>(F.wave, F.lds + RING_OFF, g, So, E); }
        }
        SEAM(P0 + 6);
        if (IN(P0 + 7)) {
            pg8::Gemm g{HB, (const pg8::bf16_t*)(wl + W_PG), M, D, D}; pg8::StaticOrder So; So.init(M, D, F.G, (int)blockIdx.x, SMALL_WGM);
            pg8::EpiRes<2, false> E{HB, HB2, SSQP, PP};
            pg8::gemm_phase<pg8::EpiRes<2, false>, pg8::StaticOrder, true, true>(F.wave, F.lds + RING_OFF, g, So, E);
        }
        SEAM(P0 + 7);
    }
    if (IN(PH_FINAL)) {
        const float* fw = a.in[I_FNW]; const int gw = blockIdx.x * NWAVES + F.wave, NGW = F.G * NWAVES, lane = LANE();
        f32x4 wv[4];
#pragma unroll
        for (int j = 0; j < 4; ++j) wv[j] = ((const f32x4*)fw)[2 * lane + 128 * (j >> 1) + (j & 1)];
        for (int m0 = gw; m0 < M; m0 += 2 * NGW) {
            v4u w0[2], w1[2]; float sp_[2];
#pragma unroll
            for (int k = 0; k < 2; ++k) { const int m = (m0 + k * NGW < M) ? m0 + k * NGW : m0; const v4u* src = (const v4u*)(HB2 + (size_t)m * D) + lane; w0[k] = src[0]; w1[k] = src[64]; sp_[k] = (lane < 16) ? SSQP[(size_t)m * 16 + lane] : 0.f; }
#pragma unroll
            for (int k = 0; k < 2; ++k) { const int m = (m0 + k * NGW < M) ? m0 + k * NGW : m0; f32x4* dst = (f32x4*)(H + (size_t)m * D) + 2 * lane; float s = sp_[k];
                s += shfl_f(s, lane ^ 1); s += shfl_f(s, lane ^ 2); s += shfl_f(s, lane ^ 4); s += shfl_f(s, lane ^ 8);
                const float rs = rsqrtf(shfl_f(s, 0) * (1.f / D) + EPS);
                float v0[8], v1[8]; mx::unpack8(w0[k], v0); mx::unpack8(w1[k], v1);
                dst[0] = (f32x4){v0[0], v0[1], v0[2], v0[3]} * rs * wv[0]; dst[1] = (f32x4){v0[4], v0[5], v0[6], v0[7]} * rs * wv[1];
                dst[128] = (f32x4){v1[0], v1[1], v1[2], v1[3]} * rs * wv[2]; dst[129] = (f32x4){v1[4], v1[5], v1[6], v1[7]} * rs * wv[3]; }
        }
    }
#undef IN
#undef SEAM
}

extern "C" void kernel_launch(void* const* d_in, const int* in_sizes, int n_in, void* d_out, int out_size, void* d_ws, size_t ws_size, hipStream_t stream) {
    static int grid = 0;
    if (grid == 0) {
        if (n_in != 27 || in_sizes[0] != M * D || out_size != M * D || ws_size < WS_END) { fprintf(stderr, "kernel_launch: unexpected shapes (n_in %d, ws %zu)\n", n_in, ws_size); grid = -1; return; }
        int dev = 0, cus = 0, per_cu = 0;
        if (hipGetDevice(&dev) != hipSuccess || hipDeviceGetAttribute(&cus, hipDeviceAttributeMultiprocessorCount, dev) != hipSuccess) { grid = -1; return; }
        if (hipFuncSetAttribute((const void*)mk_fwd, hipFuncAttributeMaxDynamicSharedMemorySize, LDS_BYTES) != hipSuccess) { fprintf(stderr, "kernel_launch: hipFuncSetAttribute failed\n"); grid = -1; return; }
        if (hipOccupancyMaxActiveBlocksPerMultiprocessor(&per_cu, (const void*)mk_fwd, NT, LDS_BYTES) != hipSuccess || per_cu < 1) fprintf(stderr, "kernel_launch: occupancy query reports %d\n", per_cu);
        (void)hipGetLastError();
        grid = cus;
    }
    if (grid < 0) return;
    if (hipMemsetAsync((char*)d_ws + WS_CTL, 0, CTL_ZERO_BYTES, stream) != hipSuccess) return;
    Args a{};
    for (int i = 0; i < 27; ++i) a.in[i] = (const float*)d_in[i];
    a.out = (float*)d_out; a.ws = (unsigned char*)d_ws;
#define MK(lo_, hi_, li_) do { a.ph_lo = (lo_); a.ph_hi = (hi_); a.li = (li_); hipLaunchKernelGGL(mk_fwd, dim3(grid), dim3(NT), LDS_BYTES, stream, a); } while (0)
#define NAIVE(PH, L) hipLaunchKernelGGL(naive_mix<PH>, dim3(2048), dim3(NTN), 1024, stream, a, L)
    MK(0, PH_END, 0);
}
```
